# Optimizing an MI355X kernel written in HIP

```python
import math
import jax, jax.numpy as jnp
from jax import lax
import numpy as np

D_MODEL = 2048
BATCH = 4
SEQ = 2048
DEPTH = 1
DEC_BATCH = 128
DEC_SEQ = 4
PAST_LEN = 2048
PAGE_SIZE = 128

POOL_WIDTH = D_MODEL // 2
POOL_WINDOWS = (2, 4, 8, 16)
POOL_GROUP = POOL_WIDTH // len(POOL_WINDOWS)
POOL_HIST = max(POOL_WINDOWS) - 1
N_HEADS = 16
HEAD_DIM = 64
N_KV_HEADS = 4
GROUP = N_HEADS // N_KV_HEADS
N_KV_SLOTS = 6
N_PAGED_SLOTS = 4
CMP_BLOCK = 32
SEL_BLOCK = 64
N_SELECT = 16
WINDOW = 512
FORCE_BONUS = 1.0e4
Q_BLOCK = 64
ATTN_SCALE = HEAD_DIM ** -0.5
N_BUCKETS = 32
MAX_DISTANCE = 128
D_FF = 5632
CONV_WIDTH = 3
N_BRANCHES = 2
EPS = 1e-6
Q_WIDTH = N_HEADS * HEAD_DIM
KV_WIDTH = N_KV_SLOTS * N_KV_HEADS * HEAD_DIM
SPLIT_SIZES = (POOL_WIDTH, Q_WIDTH, KV_WIDTH, 3 * N_HEADS, N_BRANCHES * D_MODEL)
IN_WIDTH = sum(SPLIT_SIZES)

kernel_name = 'hybrid_pool_nsa_convffn_decode_step'


def rmsnorm(x, g):
    xf = x.astype(jnp.float32)
    y = xf * lax.rsqrt(jnp.mean(xf * xf, axis=-1, keepdims=True) + EPS)
    return (y * g.astype(jnp.float32)).astype(x.dtype)


def rel_bucket(dist):
    n = jnp.maximum(dist, 0)
    max_exact = N_BUCKETS // 2
    nf = jnp.maximum(n, 1).astype(jnp.float32)
    large = max_exact + (jnp.log(nf / max_exact) / math.log(MAX_DISTANCE / max_exact)
                         * (N_BUCKETS - max_exact)).astype(jnp.int32)
    large = jnp.minimum(large, N_BUCKETS - 1)
    return jnp.where(n < max_exact, n, large)


def masked_softmax(s, mask):
    s = jnp.where(mask, s, -jnp.inf)
    m = jnp.max(s, axis=-1, keepdims=True)
    m = jnp.where(jnp.isfinite(m), m, 0.0)
    e = jnp.exp(s - m)
    d = jnp.sum(e, axis=-1, keepdims=True)
    return e / jnp.where(d > 0, d, 1.0)


def project_in(x, g, w_in):
    B, T, _ = x.shape
    z = rmsnorm(x, g) @ w_in
    cuts = [sum(SPLIT_SIZES[:i + 1]) for i in range(len(SPLIT_SIZES) - 1)]
    pool_in, q, kv, ng, mg = jnp.split(z, cuts, axis=-1)
    q = q.reshape(B, T, N_KV_HEADS, GROUP, HEAD_DIM)
    kv = kv.reshape(B, T, N_KV_SLOTS, N_KV_HEADS, HEAD_DIM)
    ng = ng.reshape(B, T, 3, N_KV_HEADS, GROUP)
    mg = mg.reshape(B, T, N_BRANCHES, D_MODEL)
    return pool_in, q, kv, ng, mg


def pool_mixer(x_new, hist, pos, w_grp, scale):
    T = x_new.shape[1]
    xcat = jnp.concatenate([hist, x_new], axis=1)
    xa = xcat.astype(jnp.float32)
    cs = jnp.concatenate([jnp.zeros_like(xa[:, :1]), jnp.cumsum(xa, axis=1)], axis=1)
    end = cs[:, POOL_HIST + 1:]
    outs = []
    for gi, w in enumerate(POOL_WINDOWS):
        c = slice(gi * POOL_GROUP, (gi + 1) * POOL_GROUP)
        win = end[..., c] - cs[:, POOL_HIST + 1 - w:POOL_HIST + 1 - w + T, c]
        cnt = jnp.minimum(w, pos + 1).astype(jnp.float32)[None, :, None]
        pooled = win / cnt - xa[:, POOL_HIST:, c]
        outs.append(jnp.einsum('btc,cd->btd', pooled.astype(x_new.dtype), w_grp[gi]))
    y = jnp.concatenate(outs, axis=-1) * scale
    return y, xcat[:, -POOL_HIST:]


def compress(x, pe, w1, w2):
    B, L = x.shape[:2]
    n = L // CMP_BLOCK
    blk = x[:, :n * CMP_BLOCK].reshape(B, n, CMP_BLOCK, N_KV_HEADS, HEAD_DIM) + pe[:, None, :]
    hid = jax.nn.gelu(jnp.einsum('bnlgd,lde->bnge', blk, w1), approximate=True)
    return jnp.einsum('bnge,ef->bngf', hid, w2)


def compressed_branch(q, q_pos, kc, vc, table):
    nc = kc.shape[1]
    s = jnp.einsum('btghd,bngd->bgthn', q, kc, preferred_element_type=jnp.float32) * ATTN_SCALE
    dist = q_pos[:, None] - (jnp.arange(nc) * CMP_BLOCK + CMP_BLOCK - 1)[None, :]
    bias = jnp.transpose(table[rel_bucket(dist)], (2, 0, 3, 1))[None]
    p = masked_softmax(s + bias, (dist >= 0)[None, None, :, None, :])
    o = jnp.einsum('bgthn,bngd->btghd', p.astype(vc.dtype), vc)
    return o, p


def select_blocks(p_cmp, q_pos, n_sb):
    imp = p_cmp.sum(axis=3)
    nc = imp.shape[-1]
    per = SEL_BLOCK // CMP_BLOCK
    imp = jnp.pad(imp, ((0, 0), (0, 0), (0, 0), (0, n_sb * per - nc)))
    imp = imp.reshape(imp.shape[:-1] + (n_sb, per)).sum(-1)
    blk = jnp.arange(n_sb)[None, :]
    cur = (q_pos // SEL_BLOCK)[:, None]
    forced = (blk == 0) | (blk == cur) | (blk == cur - 1)
    valid = blk * SEL_BLOCK <= q_pos[:, None]
    score = jnp.where(valid, imp + FORCE_BONUS * forced, -jnp.inf)
    _, idx = lax.top_k(score, min(N_SELECT, n_sb))
    return idx


def to_blocks(x, n_sb):
    B, L = x.shape[:2]
    x = jnp.pad(x, ((0, 0), (0, n_sb * SEL_BLOCK - L), (0, 0), (0, 0)))
    return jnp.transpose(x.reshape(B, n_sb, SEL_BLOCK, N_KV_HEADS, HEAD_DIM), (0, 3, 1, 2, 4))


def select_attend(q, q_pos, idx, ks_blk, vs_blk, table):
    B, T = q.shape[:2]
    k = idx.shape[-1]
    bi = jnp.arange(B)[:, None, None]
    gi = jnp.arange(N_KV_HEADS)[None, :, None]
    flat = idx.reshape(B, N_KV_HEADS, T * k)
    kg = ks_blk[bi, gi, flat].reshape(B, N_KV_HEADS, T, k * SEL_BLOCK, HEAD_DIM)
    vg = vs_blk[bi, gi, flat].reshape(B, N_KV_HEADS, T, k * SEL_BLOCK, HEAD_DIM)
    pos = (idx[..., None] * SEL_BLOCK + jnp.arange(SEL_BLOCK)).reshape(B, N_KV_HEADS, T, k * SEL_BLOCK)
    dist = q_pos[None, None, :, None] - pos
    s = jnp.einsum('btghd,bgtkd->bgthk', q, kg, preferred_element_type=jnp.float32) * ATTN_SCALE
    bias = table[rel_bucket(dist), gi[..., None]]
    p = masked_softmax(s + jnp.swapaxes(bias, -1, -2), (dist >= 0)[:, :, :, None, :])
    return jnp.einsum('bgthk,bgtkd->btghd', p.astype(vg.dtype), vg)


def window_attend(q, q_pos, kw, vw, k_pos, table):
    s = jnp.einsum('btghd,bkgd->bgthk', q, kw, preferred_element_type=jnp.float32) * ATTN_SCALE
    dist = q_pos[:, None] - k_pos[None, :]
    bias = jnp.transpose(table[rel_bucket(dist)], (2, 0, 3, 1))[None]
    mask = (dist >= 0) & (dist <= WINDOW) & (k_pos >= 0)[None, :]
    p = masked_softmax(s + bias, mask[None, None, :, None, :])
    return jnp.einsum('bgthk,bkgd->btghd', p.astype(vw.dtype), vw)


def nsa_core(q, q_pos, kv_full, cmp_params, table):
    pe_k, w1_k, w2_k, pe_v, w1_v, w2_v = cmp_params
    kc = compress(kv_full[:, :, 0], pe_k, w1_k, w2_k)
    vc = compress(kv_full[:, :, 1], pe_v, w1_v, w2_v)
    o_cmp, p_cmp = compressed_branch(q, q_pos, kc, vc, table)
    n_sb = -(-kv_full.shape[1] // SEL_BLOCK)
    idx = select_blocks(p_cmp, q_pos, n_sb)
    return o_cmp, idx, to_blocks(kv_full[:, :, 2], n_sb), to_blocks(kv_full[:, :, 3], n_sb)


def nsa_prompt(q, kv, cmp_params, table):
    B, T = q.shape[:2]
    q_pos = jnp.arange(T)
    o_cmp, idx, ks_blk, vs_blk = nsa_core(q, q_pos, kv[:, :, :N_PAGED_SLOTS], cmp_params, table)
    pad = ((0, 0), (WINDOW, 0), (0, 0), (0, 0))
    kw = jnp.pad(kv[:, :, 4], pad)
    vw = jnp.pad(kv[:, :, 5], pad)
    n_ch = T // Q_BLOCK
    n_top = idx.shape[-1]
    qs = jnp.moveaxis(q.reshape(B, n_ch, Q_BLOCK, N_KV_HEADS, GROUP, HEAD_DIM), 1, 0)
    ids = jnp.moveaxis(idx.reshape(B, N_KV_HEADS, n_ch, Q_BLOCK, n_top), 2, 0)

    def one_block(args):
        c, qc, ic = args
        start = c * Q_BLOCK
        qp = start + jnp.arange(Q_BLOCK)
        o_sel = select_attend(qc, qp, ic, ks_blk, vs_blk, table)
        kp = start - WINDOW + jnp.arange(Q_BLOCK + WINDOW)
        kwc = lax.dynamic_slice_in_dim(kw, start, Q_BLOCK + WINDOW, axis=1)
        vwc = lax.dynamic_slice_in_dim(vw, start, Q_BLOCK + WINDOW, axis=1)
        o_win = window_attend(qc, qp, kwc, vwc, kp, table)
        return o_sel, o_win

    o_sel, o_win = lax.map(one_block, (jnp.arange(n_ch), qs, ids))
    unblock = lambda o: jnp.moveaxis(o, 0, 1).reshape(B, T, N_KV_HEADS, GROUP, HEAD_DIM)
    return o_cmp, unblock(o_sel), unblock(o_win)


def nsa_sample(q, kv, past, win_buf, cmp_params, table):
    T = q.shape[1]
    p0 = past.shape[1]
    wb = win_buf.shape[1]
    q_pos = p0 + jnp.arange(T)
    full = jnp.concatenate([past, kv[:, :, :N_PAGED_SLOTS]], axis=1)
    o_cmp, idx, ks_blk, vs_blk = nsa_core(q, q_pos, full, cmp_params, table)
    o_sel = select_attend(q, q_pos, idx, ks_blk, vs_blk, table)
    win = jnp.concatenate([win_buf, kv[:, :, N_PAGED_SLOTS:]], axis=1)
    kp = p0 - wb + jnp.arange(wb + T)
    o_win = window_attend(q, q_pos, win[:, :, 0], win[:, :, 1], kp, table)
    return o_cmp, o_sel, o_win, win[:, -wb:]


def combine_nsa(o_cmp, o_sel, o_win, ng):
    g = jax.nn.sigmoid(ng.astype(jnp.float32)).astype(o_cmp.dtype)[..., None]
    o = g[:, :, 0] * o_cmp + g[:, :, 1] * o_sel + g[:, :, 2] * o_win
    return o.reshape(o.shape[0], o.shape[1], Q_WIDTH)


def merge_and_ffn(h, a_pool, o_nsa, mg, conv_hist, w_pool_proj, w_nsa_proj, w_out, g_post_mix,
                  g_pre_ffn, w_up, conv_w, conv_b, w_down, g_post_ffn):
    gates = jax.nn.sigmoid(mg.astype(jnp.float32)).astype(h.dtype)
    merged = gates[:, :, 0] * (a_pool @ w_pool_proj) + gates[:, :, 1] * (o_nsa @ w_nsa_proj)
    h = h + rmsnorm(merged @ w_out, g_post_mix)
    up = rmsnorm(h, g_pre_ffn) @ w_up
    val, gate = jnp.split(up, 2, axis=-1)
    T = h.shape[1]
    gcat = jnp.concatenate([conv_hist, gate], axis=1)
    conv = conv_b
    for j in range(CONV_WIDTH):
        conv = conv + conv_w[j] * gcat[:, j:j + T]
    y = (jax.nn.gelu(conv, approximate=True) * val) @ w_down
    h = h + rmsnorm(y, g_post_ffn)
    return h, gcat[:, -(CONV_WIDTH - 1):]


def setup_inputs(seed: int = 0) -> dict:
    key = jax.random.key(seed)
    k = jax.random.split(key, 32)
    f32 = jnp.float32
    n_pages = PAST_LEN // PAGE_SIZE
    n_used = DEC_BATCH * n_pages
    n_pool = n_used + max(1, n_used // 4)
    w_buf = min(WINDOW, PAST_LEN)
    nrm = lambda kk, shape, scale: scale * jax.random.normal(kk, shape, f32)
    gain = lambda kk: 1.0 + nrm(kk, (DEPTH, D_MODEL), 0.05)
    page_table = jax.random.permutation(k[0], n_pool)[:n_used].reshape(DEC_BATCH, n_pages).astype(jnp.int32)
    return {
        'x_prompt': nrm(k[1], (BATCH, SEQ, D_MODEL), 1.0),
        'x_sample': nrm(k[2], (DEC_BATCH, DEC_SEQ, D_MODEL), 1.0),
        'cache_kv': nrm(k[3], (DEPTH, n_pool, PAGE_SIZE, N_PAGED_SLOTS, N_KV_HEADS, HEAD_DIM), 1.0),
        'page_table': page_table,
        'state_kv_win': nrm(k[4], (DEPTH, DEC_BATCH, w_buf, 2, N_KV_HEADS, HEAD_DIM), 1.0),
        'state_pool': nrm(k[5], (DEPTH, DEC_BATCH, POOL_HIST, POOL_WIDTH), 1.0),
        'state_conv': nrm(k[6], (DEPTH, DEC_BATCH, CONV_WIDTH - 1, D_FF), 1.0),
        'g_pre_mix': gain(k[7]),
        'w_in': nrm(k[8], (DEPTH, D_MODEL, IN_WIDTH), D_MODEL ** -0.5),
        'pe_cmp_k': nrm(k[9], (DEPTH, CMP_BLOCK, HEAD_DIM), 0.2),
        'w1_cmp_k': nrm(k[10], (DEPTH, CMP_BLOCK, HEAD_DIM, HEAD_DIM), (CMP_BLOCK * HEAD_DIM) ** -0.5),
        'w2_cmp_k': nrm(k[11], (DEPTH, HEAD_DIM, HEAD_DIM), HEAD_DIM ** -0.5),
        'pe_cmp_v': nrm(k[12], (DEPTH, CMP_BLOCK, HEAD_DIM), 0.2),
        'w1_cmp_v': nrm(k[13], (DEPTH, CMP_BLOCK, HEAD_DIM, HEAD_DIM), (CMP_BLOCK * HEAD_DIM) ** -0.5),
        'w2_cmp_v': nrm(k[14], (DEPTH, HEAD_DIM, HEAD_DIM), HEAD_DIM ** -0.5),
        'rel_bias': nrm(k[15], (N_BUCKETS, N_HEADS), 0.5),
        'w_pool_grp': nrm(k[16], (DEPTH, len(POOL_WINDOWS), POOL_GROUP, POOL_GROUP), POOL_GROUP ** -0.5),
        'pool_scale': 1.0 + nrm(k[17], (DEPTH, POOL_WIDTH), 0.1),
        'w_pool_proj': nrm(k[18], (DEPTH, POOL_WIDTH, D_MODEL), POOL_WIDTH ** -0.5),
        'w_nsa_proj': nrm(k[19], (DEPTH, Q_WIDTH, D_MODEL), Q_WIDTH ** -0.5),
        'w_out': nrm(k[20], (DEPTH, D_MODEL, D_MODEL), D_MODEL ** -0.5),
        'g_post_mix': gain(k[21]),
        'g_pre_ffn': gain(k[22]),
        'w_up': nrm(k[23], (DEPTH, D_MODEL, 2 * D_FF), D_MODEL ** -0.5),
        'conv_w': nrm(k[24], (DEPTH, CONV_WIDTH, D_FF), CONV_WIDTH ** -0.5),
        'conv_b': nrm(k[25], (DEPTH, D_FF), 0.02),
        'w_down': nrm(k[26], (DEPTH, D_FF, D_MODEL), D_FF ** -0.5),
        'g_post_ffn': gain(k[27]),
    }


def reference(x_prompt, x_sample, cache_kv, page_table, state_kv_win, state_pool, state_conv,
              g_pre_mix, w_in, pe_cmp_k, w1_cmp_k, w2_cmp_k, pe_cmp_v, w1_cmp_v, w2_cmp_v,
              rel_bias, w_pool_grp, pool_scale, w_pool_proj, w_nsa_proj, w_out, g_post_mix,
              g_pre_ffn, w_up, conv_w, conv_b, w_down, g_post_ffn):
    table = rel_bias.reshape(N_BUCKETS, N_KV_HEADS, GROUP)
    B, T = x_prompt.shape[:2]
    Bs, Ts = x_sample.shape[:2]
    past_len = page_table.shape[1] * PAGE_SIZE
    pos_p = jnp.arange(T)
    pos_s = past_len + jnp.arange(Ts)
    hp, hs = x_prompt, x_sample
    kv_p_l, kv_s_l, win_p_l, win_s_l, pool_p_l, pool_s_l, conv_p_l, conv_s_l = ([] for _ in range(8))
    for l in range(DEPTH):
        cmp_params = (pe_cmp_k[l], w1_cmp_k[l], w2_cmp_k[l], pe_cmp_v[l], w1_cmp_v[l], w2_cmp_v[l])
        lw = (w_pool_proj[l], w_nsa_proj[l], w_out[l], g_post_mix[l], g_pre_ffn[l], w_up[l],
              conv_w[l], conv_b[l], w_down[l], g_post_ffn[l])
        pin, q, kv, ng, mg = project_in(hp, g_pre_mix[l], w_in[l])
        a, pool_new = pool_mixer(pin, jnp.zeros((B, POOL_HIST, POOL_WIDTH), pin.dtype), pos_p,
                                 w_pool_grp[l], pool_scale[l])
        o_cmp, o_sel, o_win = nsa_prompt(q, kv, cmp_params, table)
        o = combine_nsa(o_cmp, o_sel, o_win, ng)
        hp, conv_new = merge_and_ffn(hp, a, o, mg, jnp.zeros((B, CONV_WIDTH - 1, D_FF), hp.dtype), *lw)
        kv_p_l.append(kv[:, :, :N_PAGED_SLOTS])
        win_p_l.append(kv[:, T - min(WINDOW, T):, N_PAGED_SLOTS:])
        pool_p_l.append(pool_new)
        conv_p_l.append(conv_new)
        pin, q, kv, ng, mg = project_in(hs, g_pre_mix[l], w_in[l])
        a, pool_new = pool_mixer(pin, state_pool[l], pos_s, w_pool_grp[l], pool_scale[l])
        past = cache_kv[l, page_table].reshape(Bs, past_len, N_PAGED_SLOTS, N_KV_HEADS, HEAD_DIM)
        o_cmp, o_sel, o_win, win_new = nsa_sample(q, kv, past, state_kv_win[l], cmp_params, table)
        o = combine_nsa(o_cmp, o_sel, o_win, ng)
        hs, conv_new = merge_and_ffn(hs, a, o, mg, state_conv[l], *lw)
        kv_s_l.append(kv[:, :, :N_PAGED_SLOTS])
        win_s_l.append(win_new)
        pool_s_l.append(pool_new)
        conv_s_l.append(conv_new)
    return (hp, hs, jnp.stack(kv_p_l), jnp.stack(kv_s_l), jnp.stack(win_p_l), jnp.stack(win_s_l),
            jnp.stack(pool_p_l), jnp.stack(pool_s_l), jnp.stack(conv_p_l), jnp.stack(conv_s_l))
```

```cpp
#include <hip/hip_runtime.h>
#include <stdint.h>
#include <math.h>

namespace pg8 {
#define PG8_LAS __attribute__((address_space(3)))
typedef unsigned short bf16_t;
typedef short bf16x8 __attribute__((ext_vector_type(8)));
typedef float f32x4 __attribute__((ext_vector_type(4)));
typedef unsigned u32x4 __attribute__((ext_vector_type(4)));
constexpr int BM = 256, BK = 64, HALF = 128, HTB = HALF * BK * 2  , STAGE_BYTES = 8 * HTB, NXCD = 8, WGM = 8;

__host__ __device__ __forceinline__ int lds_byte(int r, int c) { const int st = (r >> 4) * 2 + (c >> 5), rr = r & 15, cc = c & 31, ob = rr * 64 + cc * 2; return st * 1024 + (ob ^ (((ob >> 9) & 1) << 5)); }
__host__ __device__ __forceinline__ void stage_rc(int b, int& R, int& C) { const int st = b / 1024, sb = b % 1024, swz = sb ^ (((sb >> 9) & 1) << 5); R = (st >> 1) * 16 + swz / 64; C = (st & 1) * 32 + (swz % 64) / 2; }
__host__ __device__ __forceinline__ int perm32(int rho) { const int n = rho >> 4, i = rho & 15; return 8 * (i >> 2) + 4 * n + (i & 3); }

struct Unit { int pm, pn, koff; };
struct Gemm { const bf16_t* A; const bf16_t* Bt; int M, N, K, lda, ldb; };
struct StaticOrder {
    int nM, nN, nwg, G, c;
    __host__ __device__ void init(int M, int N, int G_, int c_) { nM = M / BM; nN = N / BM; nwg = nM * nN; G = G_; c = c_; }
    __host__ __device__ bool next(int i, Unit& u) const {
        const long L = (long)i * G + c; if (L >= nwg) return false;
        int wgid = (int)L; { const int q = nwg / NXCD, r = nwg % NXCD, xcd = wgid % NXCD, off = wgid / NXCD; wgid = (xcd < r ? xcd * (q + 1) : r * (q + 1) + (xcd - r) * q) + off; }
        const int nig = WGM * nN, gid = wgid / nig, fm = gid * WGM, gsz = (nM - fm) < WGM ? (nM - fm) : WGM;
        u.pm = fm + ((wgid % nig) % gsz); u.pn = (wgid % nig) / gsz; u.koff = 0; return true;
    }
    __device__ __forceinline__ void a_ready(const Unit&) const {}
    __device__ __forceinline__ void done(const Unit&) const {}
};
__device__ __forceinline__ unsigned cvt_pk_bf16(float lo, float hi) { unsigned r; asm volatile("v_cvt_pk_bf16_f32 %0, %1, %2" : "=v"(r) : "v"(lo), "v"(hi)); return r; }
struct EpiF32X {
    static constexpr bool PERM = false, AFTER_DRAIN = false, HAS_MID = false;
    float* C; int ldc; int split_pn; int split_add;
    __device__ __forceinline__ void operator()(const f32x4 (&acc)[2][2][4][2], const Unit& u, int wr, int wc, int fr, int fq) const {
        const int row0 = u.pm * BM + wr * 64 + fr, col0 = u.pn * BM + (u.pn >= split_pn ? split_add : 0) + wc * 32 + 4 * fq;
#pragma unroll
        for (int ai = 0; ai < 2; ++ai)
#pragma unroll
            for (int m = 0; m < 4; ++m) { float* rowp = C + (size_t)(row0 + ai * HALF + m * 16) * ldc + col0;
#pragma unroll
                for (int bj = 0; bj < 2; ++bj)
#pragma unroll
                    for (int n = 0; n < 2; ++n) *(f32x4*)(rowp + bj * HALF + n * 16) = acc[ai][bj][m][n]; }
    }
};
struct SplitOrder {
    int G, c, S, Ks, pm0, nN;
    __device__ __forceinline__ bool next(int i, Unit& u) const { const int L = i * G + c; if (L >= 2 * nN * S) return false; const int ks = L % S, t = L / S; u.pm = pm0 + (t & 1); u.pn = t >> 1; u.koff = ks * Ks; return true; }
    __device__ __forceinline__ void a_ready(const Unit&) const {}
    __device__ __forceinline__ void done(const Unit&) const {}
};
typedef unsigned u32x2 __attribute__((ext_vector_type(2)));
struct EpiSlab {
    static constexpr bool PERM = false, AFTER_DRAIN = false, HAS_MID = false;
    unsigned short* C; int ldc; int Ks; int pm0; size_t slab;
    __device__ __forceinline__ void operator()(const f32x4 (&acc)[2][2][4][2], const Unit& u, int wr, int wc, int fr, int fq) const {
        const int row0 = (u.pm - pm0) * BM + wr * 64 + fr, col0 = u.pn * BM + wc * 32 + 4 * fq; unsigned short* base = C + (size_t)(u.koff / Ks) * slab;
#pragma unroll
        for (int ai = 0; ai < 2; ++ai)
#pragma unroll
            for (int m = 0; m < 4; ++m) { unsigned short* rowp = base + (size_t)(row0 + ai * HALF + m * 16) * ldc + col0;
#pragma unroll
                for (int bj = 0; bj < 2; ++bj)
#pragma unroll
                    for (int n = 0; n < 2; ++n) { u32x2 w; w.x = cvt_pk_bf16(acc[ai][bj][m][n][0], acc[ai][bj][m][n][1]); w.y = cvt_pk_bf16(acc[ai][bj][m][n][2], acc[ai][bj][m][n][3]);
                        *(u32x2*)(rowp + bj * HALF + n * 16) = w; } }
    }
};
template <class Epi, class Sched, bool ALIGN_EPI = false, bool SP2 = false>
__device__ __forceinline__ void gemm_phase(PG8_LAS unsigned char* lds, const Gemm g, const Sched& S, const Epi& E, const int wid) {
    int lane; asm volatile("v_mbcnt_lo_u32_b32 %0, -1, 0\n\tv_mbcnt_hi_u32_b32 %0, -1, %0" : "=v"(lane));
    const int wu = __builtin_amdgcn_readfirstlane(wid);
    const int tid = wu * 64 + lane, wr = wu >> 2, wc = wu & 3, fr = lane & 15, fq = lane >> 4;
    const int K = g.K, nt = K / BK;
    unsigned voffA[2], voffB[2];
#pragma unroll
    for (int i = 0; i < 2; ++i) { int R, C; stage_rc(tid * 16 + i * 8192, R, C); const int Rb = Epi::PERM ? ((R & ~31) + perm32(R & 31)) : R;
        voffA[i] = (unsigned)(R * g.lda + C) * 2u; voffB[i] = (unsigned)(Rb * g.ldb + C) * 2u; }
    const size_t kstep = (size_t)(BK * 2);
    const size_t hstepA = (size_t)HALF * g.lda * 2, hstepB = (size_t)HALF * g.ldb * 2;
    const size_t tstepA = 2 * hstepA, tstepB = 2 * hstepB;
    const unsigned ldsw = (unsigned)wu * 1024u;
    const int aoff = lds_byte(wr * 64 + fr, fq * 8), boff = lds_byte(wc * 32 + fr, fq * 8);
#define PG8_SA(b, h) (((b) * 2 + (h)) * HTB)
#define PG8_SB(b, h) ((4 + (b) * 2 + (h)) * HTB)
#define PG8_STAGE(bufoff, gbase, voff) do { _Pragma("unroll") for (int _i = 0; _i < 2; ++_i) \
        __builtin_amdgcn_global_load_lds((const unsigned*)((const char*)(gbase) + (voff)[_i]), (PG8_LAS unsigned*)(lds + (bufoff) + ldsw + _i * 8192), 16, 0, 0); } while (0)
#define PG8_LDA(dst, b, h) do { _Pragma("unroll") for (int m = 0; m < 4; ++m) _Pragma("unroll") for (int k = 0; k < 2; ++k) dst[m][k] = *(const PG8_LAS bf16x8*)(lds + PG8_SA(b, h) + aoff + m * 2048 + k * 1024); } while (0)
#define PG8_LDB(dst, b, h) do { _Pragma("unroll") for (int n = 0; n < 2; ++n) _Pragma("unroll") for (int k = 0; k < 2; ++k) dst[n][k] = *(const PG8_LAS bf16x8*)(lds + PG8_SB(b, h) + boff + n * 2048 + k * 1024); } while (0)
#define PG8_MMA(ai, bj, At, Bt) do { __builtin_amdgcn_s_setprio(1); _Pragma("unroll") for (int m = 0; m < 4; ++m) _Pragma("unroll") for (int n = 0; n < 2; ++n) _Pragma("unroll") for (int k = 0; k < 2; ++k) \
        acc[ai][bj][m][n] = __builtin_amdgcn_mfma_f32_16x16x32_bf16(Bt[n][k], At[m][k], acc[ai][bj][m][n], 0, 0, 0); __builtin_amdgcn_s_setprio(0); } while (0)
#define PG8_WAIT_V(n) asm volatile("s_waitcnt vmcnt(" #n ")" ::: "memory")
#define PG8_WAIT_L(n) asm volatile("s_waitcnt lgkmcnt(" #n ")" ::: "memory")
#define PG8_BAR __builtin_amdgcn_s_barrier()
#define PG8_SCHED __builtin_amdgcn_sched_barrier(0)
    Unit cur, nxt; int ui = 0;
    if (!S.next(0, cur)) return;
    f32x4 acc[2][2][4][2];
#pragma unroll
    for (int a = 0; a < 2; ++a)
#pragma unroll
        for (int b = 0; b < 2; ++b)
#pragma unroll
            for (int m = 0; m < 4; ++m)
#pragma unroll
                for (int n = 0; n < 2; ++n) acc[a][b][m][n] = (f32x4){0.f, 0.f, 0.f, 0.f};
    bf16x8 At[4][2], B0[2][2], B1[2][2];
    const char* cA = (const char*)g.A + (size_t)cur.pm * tstepA + (size_t)cur.koff * 2; const char* cB = (const char*)g.Bt + (size_t)cur.pn * tstepB + (size_t)cur.koff * 2;
    S.a_ready(cur);
    if constexpr (SP2) {
        PG8_STAGE(PG8_SB(0, 0), cB, voffB); PG8_STAGE(PG8_SB(0, 1), cB + hstepB, voffB); PG8_STAGE(PG8_SA(0, 0), cA, voffA); PG8_STAGE(PG8_SA(0, 1), cA + hstepA, voffA);
        if (wr == 1) PG8_BAR;
        PG8_WAIT_V(2); PG8_BAR;
        PG8_STAGE(PG8_SB(1, 0), cB + kstep, voffB); PG8_STAGE(PG8_SA(1, 0), cA + kstep, voffA); PG8_STAGE(PG8_SB(1, 1), cB + hstepB + kstep, voffB);
        PG8_WAIT_V(6); PG8_BAR;
    } else {
        PG8_STAGE(PG8_SB(0, 0), cB, voffB); PG8_STAGE(PG8_SA(0, 0), cA, voffA); PG8_STAGE(PG8_SB(0, 1), cB + hstepB, voffB); PG8_STAGE(PG8_SA(0, 1), cA + hstepA, voffA);
        if (wr == 1) PG8_BAR;
        PG8_WAIT_V(4); PG8_BAR;
        PG8_STAGE(PG8_SB(1, 0), cB + kstep, voffB); PG8_STAGE(PG8_SA(1, 0), cA + kstep, voffA); PG8_STAGE(PG8_SB(1, 1), cB + hstepB + kstep, voffB);
        PG8_WAIT_V(6); PG8_BAR;
    }
    for (;;) {
        const bool has_next = S.next(ui + 1, nxt);
        const char* nA = has_next ? (const char*)g.A + (size_t)nxt.pm * tstepA + (size_t)nxt.koff * 2 : cA; const char* nB = has_next ? (const char*)g.Bt + (size_t)nxt.pn * tstepB + (size_t)nxt.koff * 2 : cB;
        for (int t = 0; t < nt; t += 2) {
            const bool last = (t == nt - 2);
            const char* a1 = cA + (size_t)(t + 1) * kstep;
            const char* a2 = last ? nA : cA + (size_t)(t + 2) * kstep; const char* b2 = last ? nB : cB + (size_t)(t + 2) * kstep;
            const char* a3 = a2 + kstep; const char* b3 = b2 + kstep;
            if (last && has_next) S.a_ready(nxt);
            if constexpr (Epi::HAS_MID) { if (t == (nt >> 1)) E.mid(acc, cur, wr, wc, fr, fq); }
            if constexpr (SP2) {
            PG8_LDB(B0, 0, 0); PG8_LDB(B1, 0, 1); PG8_SCHED; PG8_LDA(At, 0, 0); PG8_STAGE(PG8_SA(1, 1), a1 + hstepA, voffA);
            PG8_WAIT_V(8); PG8_WAIT_L(0); PG8_BAR; PG8_MMA(0, 0, At, B0); PG8_MMA(0, 1, At, B1); PG8_BAR; PG8_SCHED;
            PG8_LDA(At, 0, 1); PG8_STAGE(PG8_SB(0, 0), b2, voffB); PG8_STAGE(PG8_SB(0, 1), b2 + hstepB, voffB); PG8_STAGE(PG8_SA(0, 0), a2, voffA);
            PG8_WAIT_V(8); PG8_WAIT_L(0); PG8_BAR; PG8_MMA(1, 0, At, B0); PG8_MMA(1, 1, At, B1); PG8_BAR; PG8_SCHED;
            PG8_LDB(B0, 1, 0); PG8_LDB(B1, 1, 1); PG8_SCHED; PG8_LDA(At, 1, 0); PG8_STAGE(PG8_SA(0, 1), a2 + hstepA, voffA);
            PG8_WAIT_V(8); PG8_WAIT_L(0); PG8_BAR; PG8_MMA(0, 0, At, B0); PG8_MMA(0, 1, At, B1); PG8_BAR; PG8_SCHED;
            PG8_LDA(At, 1, 1); PG8_STAGE(PG8_SB(1, 0), b3, voffB); PG8_STAGE(PG8_SB(1, 1), b3 + hstepB, voffB); PG8_STAGE(PG8_SA(1, 0), a3, voffA);
            PG8_WAIT_V(8); PG8_WAIT_L(0); PG8_BAR; PG8_MMA(1, 0, At, B0); PG8_MMA(1, 1, At, B1); PG8_BAR; PG8_SCHED;
            } else {
            PG8_LDB(B0, 0, 0); PG8_SCHED; PG8_LDA(At, 0, 0); PG8_STAGE(PG8_SA(1, 1), a1 + hstepA, voffA);
            PG8_WAIT_L(8); PG8_BAR; PG8_WAIT_L(0); PG8_MMA(0, 0, At, B0); PG8_BAR; PG8_SCHED;
            PG8_LDB(B1, 0, 1); PG8_STAGE(PG8_SB(0, 0), b2, voffB);
            PG8_BAR; PG8_WAIT_L(0); PG8_MMA(0, 1, At, B1); PG8_BAR;
            PG8_LDA(At, 0, 1); PG8_STAGE(PG8_SA(0, 0), a2, voffA);
            PG8_BAR; PG8_WAIT_L(0); PG8_MMA(1, 0, At, B0); PG8_BAR; PG8_SCHED;
            PG8_STAGE(PG8_SB(0, 1), b2 + hstepB, voffB);
            PG8_WAIT_V(6); PG8_BAR; PG8_MMA(1, 1, At, B1); PG8_BAR;
            PG8_LDB(B0, 1, 0); PG8_SCHED; PG8_LDA(At, 1, 0); PG8_STAGE(PG8_SA(0, 1), a2 + hstepA, voffA);
            PG8_WAIT_L(8); PG8_BAR; PG8_WAIT_L(0); PG8_MMA(0, 0, At, B0); PG8_BAR; PG8_SCHED;
            PG8_LDB(B1, 1, 1); PG8_STAGE(PG8_SB(1, 0), b3, voffB);
            PG8_BAR; PG8_WAIT_L(0); PG8_MMA(0, 1, At, B1); PG8_BAR;
            PG8_LDA(At, 1, 1); PG8_STAGE(PG8_SA(1, 0), a3, voffA);
            PG8_BAR; PG8_WAIT_L(0); PG8_MMA(1, 0, At, B0); PG8_BAR; PG8_SCHED;
            PG8_STAGE(PG8_SB(1, 1), b3 + hstepB, voffB);
            PG8_WAIT_V(6); PG8_BAR; PG8_MMA(1, 1, At, B1); PG8_BAR;
            }
        }
        if constexpr (ALIGN_EPI) { if (wr == 0) PG8_BAR; }
        if constexpr (!Epi::AFTER_DRAIN) { E(acc, cur, wr, wc, fr, fq); S.done(cur); }
        if (!has_next) break;
#pragma unroll
        for (int a = 0; a < 2; ++a)
#pragma unroll
            for (int b = 0; b < 2; ++b)
#pragma unroll
                for (int m = 0; m < 4; ++m)
#pragma unroll
                    for (int n = 0; n < 2; ++n) acc[a][b][m][n] = (f32x4){0.f, 0.f, 0.f, 0.f};
        cur = nxt; cA = nA; cB = nB; ++ui;
        if constexpr (ALIGN_EPI) { if (wr == 1) PG8_BAR; }
    }
    PG8_WAIT_V(0);
    if constexpr (!ALIGN_EPI) { if (wr == 0) PG8_BAR; }
    PG8_BAR;
    if constexpr (Epi::AFTER_DRAIN) { E.fused(acc, cur, wr, wc, fr, fq, lds, wid, lane); S.done(cur); }
#undef PG8_SA
#undef PG8_SB
#undef PG8_STAGE
#undef PG8_LDA
#undef PG8_LDB
#undef PG8_MMA
#undef PG8_WAIT_V
#undef PG8_WAIT_L
#undef PG8_BAR
#undef PG8_SCHED
}
}

namespace {
typedef unsigned short bf16_t;
#define LAS __attribute__((address_space(3)))
constexpr int D = 2048, BP = 4, TP = 2048, BS = 128, TS = 4, PAST = 2048;
constexpr int MP = BP * TP, MS = BS * TS, M = MP + MS;
constexpr int PW = 1024;
constexpr int INW = 7728, ZQ = 1024, ZKV = 2048, ZNG = 3584, ZMG = 3632;
constexpr int NIN = 7680;
constexpr int FF = 5632;
constexpr int NB = BP + BS;
constexpr float EPS = 1e-6f;

constexpr size_t O_YP = 0;
constexpr size_t O_YS = O_YP + (size_t)MP * D;
constexpr size_t O_KVP = O_YS + (size_t)MS * D;
constexpr size_t O_KVS = O_KVP + (size_t)MP * 1024;
constexpr size_t O_WINP = O_KVS + (size_t)MS * 1024;
constexpr size_t O_WINS = O_WINP + (size_t)BP * 512 * 512;
constexpr size_t O_POOLP = O_WINS + (size_t)BS * 512 * 512;
constexpr size_t O_POOLS = O_POOLP + (size_t)BP * 15 * 1024;
constexpr size_t O_CONVP = O_POOLS + (size_t)BS * 15 * 1024;
constexpr size_t O_CONVS = O_CONVP + (size_t)BP * 2 * FF;
constexpr size_t O_END = O_CONVS + (size_t)BS * 2 * FF;

constexpr size_t W_POOLIN = 0;
constexpr size_t W_H1 = W_POOLIN + (size_t)M * PW;
constexpr size_t W_NGS = W_H1 + (size_t)M * D;
constexpr size_t W_C1 = W_NGS + (size_t)M * 48;
constexpr size_t W_FIXV = W_C1 + 128;
constexpr size_t W_FIXG = W_FIXV + (size_t)512 * FF;
constexpr size_t W_TAILG = W_FIXG + (size_t)512 * FF;
constexpr size_t W_SLAB = W_TAILG + (size_t)256 * FF;
constexpr size_t W_SLABM = W_SLAB + (size_t)11 * MS * D;
constexpr size_t W_END = W_SLABM + (size_t)8 * MS * D;
constexpr size_t H_UB = 0;
constexpr size_t H_XCAT = H_UB + (size_t)M * D;
constexpr size_t H_MERGEDB = H_XCAT + (size_t)M * D;
constexpr size_t H_U2B = H_MERGEDB + (size_t)M * D;
constexpr size_t H_UPB = H_U2B + (size_t)M * D;
constexpr size_t H_ACTB = H_UPB + (size_t)M * 2 * FF;
constexpr size_t H_GATEB = H_ACTB + (size_t)M * FF;
constexpr size_t H_WTIN = H_GATEB + (size_t)M * 4096;
constexpr size_t H_WTNG = H_WTIN + (size_t)NIN * D;
constexpr size_t H_WTPN = H_WTNG + (size_t)64 * D;
constexpr size_t H_WTOUT = H_WTPN + (size_t)D * D;
constexpr size_t H_WTUP = H_WTOUT + (size_t)D * D;
constexpr size_t H_WTDOWN = H_WTUP + (size_t)2 * FF * D;
constexpr size_t H_QB = H_WTDOWN + (size_t)D * FF;
constexpr size_t H_KVB = H_QB + (size_t)M * 1024;
constexpr size_t H_KCB = H_KVB + (size_t)4 * M * 256;
constexpr size_t H_VCB = H_KCB + (size_t)NB * 64 * 256;
constexpr size_t H_W1F = H_VCB + (size_t)NB * 64 * 256;
constexpr size_t H_W2F = H_W1F + (size_t)2 * 64 * 4 * 512;
constexpr size_t H_TB = H_W2F + (size_t)2 * 2 * 4 * 512;
constexpr size_t H_END = H_TB + (size_t)MP * D;
constexpr size_t WS_CTL_BYTES = 1u << 20;
constexpr size_t WS_F32_OFF = WS_CTL_BYTES;
constexpr size_t WS_H_OFF = WS_F32_OFF + ((W_END * 4 + 255) / 256) * 256;
constexpr size_t WS_TOTAL = WS_H_OFF + H_END * 2;

__device__ const unsigned char BUCKET[128] = {0, 1, 2, 3, 4, 5, 6, 7, 8, 9, 10, 11, 12, 13, 14, 15, 16, 16, 16, 17, 17, 18, 18, 18, 19, 19, 19, 20, 20, 20, 20, 21, 21, 21, 21, 22, 22, 22, 22, 22, 23, 23, 23, 23, 23, 23, 24, 24, 24, 24, 24, 24, 25, 25, 25, 25, 25, 25, 25, 26, 26, 26, 26, 26, 26, 26, 26, 27, 27, 27, 27, 27, 27, 27, 27, 27, 27, 28, 28, 28, 28, 28, 28, 28, 28, 28, 28, 29, 29, 29, 29, 29, 29, 29, 29, 29, 29, 29, 29, 30, 30, 30, 30, 30, 30, 30, 30, 30, 30, 30, 30, 30, 30, 31, 31, 31, 31, 31, 31, 31, 31, 31, 31, 31, 31, 31, 31, 31};

struct Ptrs {
    const float *xp, *xs, *cache; const int* pt; const float *swin, *spool, *sconv, *g_pre, *w_in, *pe_k, *w1_k, *w2_k, *pe_v, *w1_v, *w2_v, *rel_bias, *w_pgrp, *pool_scale,
        *w_pproj, *w_nproj, *w_out, *g_pmix, *g_pffn, *w_up, *conv_w, *conv_b, *w_down, *g_postffn;
    float* out; float* ws;
    bf16_t *ub, *xcat, *mergedb, *u2b, *upb, *actb, *gateb, *wt_in, *wt_ng, *wt_pn, *wt_out, *wt_up, *wt_down, *qb, *kvb, *kcb, *vcb, *w1f, *w2f, *tb; float *ngs, *c1;
};

__device__ __forceinline__ unsigned f2bf(float f) { unsigned u = __builtin_bit_cast(unsigned, f); return (u + 0x7fffu + ((u >> 16) & 1u)) >> 16; }
#if defined(__HIP_DEVICE_COMPILE__)
typedef float pk_f32x2 __attribute__((ext_vector_type(2))); typedef __bf16 pk_bf16x2 __attribute__((ext_vector_type(2)));
__device__ __forceinline__ unsigned pk2(float lo, float hi) { const pk_f32x2 v = {lo, hi}; const pk_bf16x2 b = __builtin_convertvector(v, pk_bf16x2); return __builtin_bit_cast(unsigned, b); }
#else
__device__ __forceinline__ unsigned pk2(float lo, float hi) { return f2bf(lo) | (f2bf(hi) << 16); }
#endif
typedef unsigned v4u __attribute__((ext_vector_type(4)));
__device__ __forceinline__ void st_bf16x4(bf16_t* p, float4 v) { uint2 o; o.x = pk2(v.x, v.y); o.y = pk2(v.z, v.w); *(uint2*)p = o; }

__device__ __forceinline__ float wave_sum(float v) {
#pragma unroll
    for (int o = 1; o < 64; o <<= 1) v += __shfl_xor(v, o);
    return v;
}
__device__ __forceinline__ float wave_max(float v) {
#pragma unroll
    for (int o = 1; o < 64; o <<= 1) v = fmaxf(v, __shfl_xor(v, o));
    return v;
}
__device__ __forceinline__ float gelu_tanh(float x) { const float y2 = 1.5957691216057308f * (x + 0.044715f * x * x * x); return x * __builtin_amdgcn_rcpf(1.0f + __builtin_amdgcn_exp2f(-y2 * 1.4426950408889634f)); }
__device__ __forceinline__ float sigmoidf(float x) { return 1.0f / (1.0f + expf(-x)); }
__device__ __forceinline__ const float* xrow(const Ptrs& P, int m) { return m < MP ? P.xp + (size_t)m * D : P.xs + (size_t)(m - MP) * D; }

struct F8 { float v[8]; };
__device__ __forceinline__ F8 ld8f(const float* p) { const float4 a = *(const float4*)p, b = *(const float4*)(p + 4); F8 r; r.v[0] = a.x; r.v[1] = a.y; r.v[2] = a.z; r.v[3] = a.w; r.v[4] = b.x; r.v[5] = b.y; r.v[6] = b.z; r.v[7] = b.w; return r; }
__device__ __forceinline__ F8 ld8h(const bf16_t* p) { const v4u t = *(const v4u*)p; F8 r; r.v[0] = __builtin_bit_cast(float, t.x << 16); r.v[1] = __builtin_bit_cast(float, t.x & 0xffff0000u); r.v[2] = __builtin_bit_cast(float, t.y << 16); r.v[3] = __builtin_bit_cast(float, t.y & 0xffff0000u);
    r.v[4] = __builtin_bit_cast(float, t.z << 16); r.v[5] = __builtin_bit_cast(float, t.z & 0xffff0000u); r.v[6] = __builtin_bit_cast(float, t.w << 16); r.v[7] = __builtin_bit_cast(float, t.w & 0xffff0000u); return r; }
__device__ __forceinline__ void st8f(float* p, const F8& r) { *(float4*)p = make_float4(r.v[0], r.v[1], r.v[2], r.v[3]); *(float4*)(p + 4) = make_float4(r.v[4], r.v[5], r.v[6], r.v[7]); }
__device__ __forceinline__ void st8h(bf16_t* p, const F8& r) { v4u t; t.x = pk2(r.v[0], r.v[1]); t.y = pk2(r.v[2], r.v[3]); t.z = pk2(r.v[4], r.v[5]); t.w = pk2(r.v[6], r.v[7]); *(v4u*)p = t; }
template <int MODE, int U, int NS>
__device__ __forceinline__ void rms_rows(const Ptrs& P, int row_lo, int row_hi, int gwave, int nwaves, int lane) {
    for (int m0 = row_lo + gwave; m0 < row_hi; m0 += U * nwaves) {
        F8 v[U][4], a[U][4]; bool ok[U]; int mm[U];
#pragma unroll
        for (int u = 0; u < U; ++u) { const int m = m0 + u * nwaves; ok[u] = m < row_hi; mm[u] = ok[u] ? m : m0;
            const float* aux = xrow(P, mm[u]); const bf16_t* h1b = (const bf16_t*)(P.ws + W_H1) + (size_t)mm[u] * D;
#pragma unroll
            for (int j = 0; j < 4; ++j) { const int c = 8 * (64 * j + lane);
                if (MODE == 0) v[u][j] = ld8f(xrow(P, mm[u]) + c);
                else if (NS > 0) v[u][j] = ld8h((const bf16_t*)(P.ws + W_SLAB) + (size_t)(mm[u] - MP) * D + c);
                else v[u][j] = ld8h(P.tb + (size_t)mm[u] * D + c);
                if (MODE == 1) a[u][j] = ld8f(aux + c); else if (MODE == 2) a[u][j] = ld8h(h1b + c); }
#pragma unroll 5
            for (int k = 1; k < NS; ++k)
#pragma unroll
                for (int j = 0; j < 4; ++j) { const F8 t = ld8h((const bf16_t*)(P.ws + W_SLAB) + (size_t)k * MS * D + (size_t)(mm[u] - MP) * D + 8 * (64 * j + lane));
#pragma unroll
                    for (int e = 0; e < 8; ++e) v[u][j].v[e] += t.v[e]; } }
#pragma unroll
        for (int u = 0; u < U; ++u) {
            float ss = 0.f;
#pragma unroll
            for (int j = 0; j < 4; ++j)
#pragma unroll
                for (int e = 0; e < 8; ++e) ss += v[u][j].v[e] * v[u][j].v[e];
            ss = wave_sum(ss);
            const float r = rsqrtf(ss * (1.0f / D) + EPS); const int m = mm[u];
            if (MODE == 0) {
                if (ok[u]) {
#pragma unroll
                    for (int j = 0; j < 4; ++j) { const int c = 8 * (64 * j + lane); const F8 g = ld8f(P.g_pre + c); F8 o;
#pragma unroll
                        for (int e = 0; e < 8; ++e) o.v[e] = v[u][j].v[e] * r * g.v[e];
                        st8h(P.ub + (size_t)m * D + c, o); } }
            } else if (MODE == 1) {
                float s2 = 0.f;
#pragma unroll
                for (int j = 0; j < 4; ++j) { const int c = 8 * (64 * j + lane); const F8 g = ld8f(P.g_pmix + c); F8 o;
#pragma unroll
                    for (int e = 0; e < 8; ++e) { o.v[e] = a[u][j].v[e] + v[u][j].v[e] * r * g.v[e]; s2 += o.v[e] * o.v[e]; }
                    if (ok[u]) st8h((bf16_t*)(P.ws + W_H1) + (size_t)m * D + c, o); v[u][j] = o; }
                s2 = wave_sum(s2); const float r2 = rsqrtf(s2 * (1.0f / D) + EPS);
                if (ok[u]) {
#pragma unroll
                    for (int j = 0; j < 4; ++j) { const int c = 8 * (64 * j + lane); const F8 g = ld8f(P.g_pffn + c); F8 o;
#pragma unroll
                        for (int e = 0; e < 8; ++e) o.v[e] = v[u][j].v[e] * r2 * g.v[e];
                        st8h(P.u2b + (size_t)m * D + c, o); } }
            } else {
                float* orow = m < MP ? P.out + O_YP + (size_t)m * D : P.out + O_YS + (size_t)(m - MP) * D;
                if (ok[u]) {
#pragma unroll
                    for (int j = 0; j < 4; ++j) { const int c = 8 * (64 * j + lane); const F8 g = ld8f(P.g_postffn + c); F8 o;
#pragma unroll
                        for (int e = 0; e < 8; ++e) o.v[e] = a[u][j].v[e] + v[u][j].v[e] * r * g.v[e];
                        st8f(orow + c, o); } }
            }
        }
    }
}
template <int MODE>
__device__ __forceinline__ void rms_stage(const Ptrs& P, int gwave, int nwaves, int lane) {
    if (MODE == 0) rms_rows<0, 2, 0>(P, 0, M, gwave, nwaves, lane);
    else { rms_rows<MODE, 2, 0>(P, 0, MP, gwave, nwaves, lane);
           rms_rows<MODE, 1, (MODE == 1 ? 8 : 11)>(P, MP, M, (gwave & 7) * (nwaves >> 3) + (gwave >> 3), nwaves, lane); }
}

struct TrItem { const float* src; int ldw; bf16_t* dst; int K; };
__device__ __forceinline__ TrItem tr_decode(const Ptrs& P, int it, int lane) {
    constexpr int I_A = (D / 64) * (3584 / 32), I_MG = (D / 64) * (4096 / 32), I_N = (1024 / 64) * (D / 32), I_O = (D / 64) * (D / 32), I_UP = (D / 64) * (2 * FF / 32);
    const float* W; int ldw, nblk, K; bf16_t* WT; int r = it; bool upmap = false;
    if (r < I_A) { W = P.w_in; ldw = INW; nblk = 3584 / 32; K = D; WT = P.wt_in; }
    else if ((r -= I_A) < I_MG) { W = P.w_in + ZMG; ldw = INW; nblk = 4096 / 32; K = D; WT = P.wt_in + (size_t)3584 * D; }
    else if ((r -= I_MG) < I_N) { W = P.w_nproj; ldw = D; nblk = D / 32; K = D; WT = P.wt_pn + 1024; }
    else if ((r -= I_N) < I_O) { W = P.w_out; ldw = D; nblk = D / 32; K = D; WT = P.wt_out; }
    else if ((r -= I_O) < I_UP) { W = P.w_up; ldw = 2 * FF; nblk = 2 * FF / 32; K = D; WT = P.wt_up; upmap = true; }
    else { r -= I_UP; W = P.w_down; ldw = D; nblk = D / 32; K = FF; WT = P.wt_down; }
    const int kb = r / nblk, nb = r % nblk, k0 = 64 * kb, n0 = 32 * nb;
    int nd = n0;
    if (upmap) { const int half = n0 >= FF, f0 = half ? n0 - FF : n0; nd = (f0 >> 7) * 256 + half * 128 + (f0 & 127); }
    TrItem t; t.src = W + (size_t)(k0 + (lane >> 3)) * ldw + n0 + (lane & 7) * 4; t.ldw = ldw; t.dst = WT + (size_t)nd * K + k0; t.K = K; return t;
}
constexpr int TR_P0 = (D / 64) * (3584 / 32) + (D / 64) * (4096 / 32) + (1024 / 64) * (D / 32), TR_O = TR_P0 + (D / 64) * (D / 32), TR_UP = TR_O + (D / 64) * (2 * FF / 32), TR_ALL = TR_UP + (FF / 64) * (D / 32);
constexpr int TR_SLOTA = TR_O + 5120;
__device__ __forceinline__ void prologue_transposes(const Ptrs& P, unsigned char* lds, int it_lo, int it_hi, int gwave, int nwaves, int wave, int lane) {
    LAS float* scr = (LAS float*)((LAS unsigned char*)lds + wave * 16384);
    const int NITEMS = it_hi;
    const int kk = lane >> 3, n4 = (lane & 7) * 4, c = lane & 7;
    int it = it_lo + gwave; if (it >= NITEMS) return;
    TrItem cur = tr_decode(P, it, lane);
    float4 x[8];
#pragma unroll
    for (int i = 0; i < 8; ++i) x[i] = *(const float4*)(cur.src + (size_t)(8 * i) * cur.ldw);
    for (;;) {
        const int itn = it + nwaves; const bool more = itn < NITEMS;
        const TrItem nxt = tr_decode(P, more ? itn : it, lane);
        float4 xn[8];
#pragma unroll
        for (int i = 0; i < 8; ++i) xn[i] = *(const float4*)(nxt.src + (size_t)(8 * i) * nxt.ldw);
#pragma unroll
        for (int i = 0; i < 8; ++i) { LAS float* d = scr + (kk + 8 * i) * 33 + n4; d[0] = x[i].x; d[1] = x[i].y; d[2] = x[i].z; d[3] = x[i].w; }
        asm volatile("s_waitcnt lgkmcnt(0)" ::: "memory");
#pragma unroll
        for (int j = 0; j < 4; ++j) { const int n = (lane >> 3) + 8 * j; const LAS float* sp = scr + (8 * c) * 33 + n;
            v4u o; o.x = pk2(sp[0 * 33], sp[1 * 33]); o.y = pk2(sp[2 * 33], sp[3 * 33]); o.z = pk2(sp[4 * 33], sp[5 * 33]); o.w = pk2(sp[6 * 33], sp[7 * 33]);
            *(v4u*)(cur.dst + (size_t)n * cur.K + 8 * c) = o; }
        asm volatile("s_waitcnt lgkmcnt(0)" ::: "memory");
        if (!more) break;
#pragma unroll
        for (int i = 0; i < 8; ++i) x[i] = xn[i];
        cur = nxt; it = itn;
    }
}
__device__ __forceinline__ void prologue_ng(const Ptrs& P, size_t gtid, size_t nthr) {
    for (size_t i = gtid; i < (size_t)64 * D; i += nthr) { const int n = (int)(i >> 11), k = (int)(i & 2047); P.wt_ng[i] = (bf16_t)(n < 48 ? f2bf(P.w_in[(size_t)k * INW + ZNG + n]) : 0u); }
}
__device__ __forceinline__ void prologue_wprime(const Ptrs& P, float* lds, int bid, int nblk, int tid) {
    float (*As)[68] = (float (*)[68])lds; float (*Bs)[132] = (float (*)[132])(lds + 16 * 68);
    const int ty = tid >> 5, tx = tid & 31;
    for (int tile = bid; tile < 256; tile += nblk) {
        const int gi = tile >> 6, tm = (tile >> 4) & 3, tn = tile & 15;
        const float* A = P.w_pgrp + (size_t)gi * 65536; const float* B = P.w_pproj + (size_t)gi * 256 * D; const float* ks = P.pool_scale + gi * 256;
        float acc[4][4];
#pragma unroll
        for (int i = 0; i < 4; ++i)
#pragma unroll
            for (int j = 0; j < 4; ++j) acc[i][j] = 0.f;
        const int ar = (tid >> 2) & 63, akq = (tid & 3) * 4; const int bk = tid >> 5, bn = (tid & 31) * 4;
        for (int k0 = 0; k0 < 256; k0 += 16) {
            float4 av = *(const float4*)(A + (size_t)(tm * 64 + ar) * 256 + k0 + akq); const float4 sv = *(const float4*)(ks + k0 + akq);
            av.x *= sv.x; av.y *= sv.y; av.z *= sv.z; av.w *= sv.w;
            const float4 bv = *(const float4*)(B + (size_t)(k0 + bk) * D + tn * 128 + bn);
            __syncthreads();
            if (tid < 256) { As[akq + 0][ar] = av.x; As[akq + 1][ar] = av.y; As[akq + 2][ar] = av.z; As[akq + 3][ar] = av.w; }
            *(float4*)&Bs[bk][bn] = bv;
            __syncthreads();
#pragma unroll
            for (int k = 0; k < 16; ++k) {
                const float4 a0 = *(const float4*)&As[k][ty * 4], b = *(const float4*)&Bs[k][tx * 4];
                const float a[4] = {a0.x, a0.y, a0.z, a0.w}; const float bb[4] = {b.x, b.y, b.z, b.w};
#pragma unroll
                for (int i = 0; i < 4; ++i)
#pragma unroll
                    for (int j = 0; j < 4; ++j) acc[i][j] = fmaf(a[i], bb[j], acc[i][j]);
            }
        }
#pragma unroll
        for (int j = 0; j < 4; ++j) { const int col = tn * 128 + tx * 4 + j; const int row = gi * 256 + tm * 64 + ty * 4;
            uint2 o; o.x = pk2(acc[0][j], acc[1][j]); o.y = pk2(acc[2][j], acc[3][j]); *(uint2*)(P.wt_pn + (size_t)col * D + row) = o; }
    }
}
typedef short bf16x8_t __attribute__((ext_vector_type(8)));
typedef float f32x4_t __attribute__((ext_vector_type(4)));
__device__ __forceinline__ void ng_stage(const Ptrs& P, int bid, int nblk, int wave, int lane) {
    const int r16 = lane & 15, kq = lane >> 4;
    for (int task = wave * nblk + bid; task < M / 16; task += 8 * nblk) {
        const bf16_t* arow = P.ub + (size_t)(task * 16 + r16) * D + 8 * kq;
        const bf16_t* brow = P.wt_ng + (size_t)r16 * D + 8 * kq;
        f32x4_t acc[3] = {{0.f, 0.f, 0.f, 0.f}, {0.f, 0.f, 0.f, 0.f}, {0.f, 0.f, 0.f, 0.f}};
#pragma unroll 4
        for (int ks = 0; ks < D / 32; ++ks) {
            const bf16x8_t a = *(const bf16x8_t*)(arow + 32 * ks);
#pragma unroll
            for (int nt = 0; nt < 3; ++nt) { const bf16x8_t b = *(const bf16x8_t*)(brow + (size_t)nt * 16 * D + 32 * ks); acc[nt] = __builtin_amdgcn_mfma_f32_16x16x32_bf16(a, b, acc[nt], 0, 0, 0); }
        }
#pragma unroll
        for (int nt = 0; nt < 3; ++nt)
#pragma unroll
            for (int r = 0; r < 4; ++r) P.ngs[(size_t)(task * 16 + kq * 4 + r) * 48 + nt * 16 + r16] = sigmoidf(acc[nt][r]);
    }
}
template <int R, bool PROMPT>
__device__ __forceinline__ void compress_mfma(const Ptrs& P, int gwave, int nwaves, int lane) {
    const int r16 = lane & 15, kq = lane >> 4, n4 = r16 >> 2, g = r16 & 3;
    const int ntask = (PROMPT ? BP * 16 : BS * 16) / R * 2;
    for (int task = gwave; task < ntask; task += nwaves) {
        const int slot = task & 1, pgp = task >> 1;
        const float* rowp[R]; int obase[R]; int stride;
#pragma unroll
        for (int rr = 0; rr < R; ++rr) { const int pgi = pgp * R + rr, b = pgi >> 4, pg = pgi & 15;
            if (PROMPT) { stride = 1024; rowp[rr] = P.out + O_KVP + (size_t)(b * TP + pg * 128 + n4 * 32) * 1024 + slot * 256 + g * 64 + 8 * kq; obase[rr] = (((b) * 64 + pg * 4 + n4) * 4 + g) * 64; }
            else { stride = 1024; const int page = P.pt[b * 16 + pg]; rowp[rr] = P.cache + ((size_t)page * 128 + n4 * 32) * 1024 + slot * 256 + g * 64 + 8 * kq; obase[rr] = (((BP + b) * 64 + pg * 4 + n4) * 4 + g) * 64; } }
        f32x4_t acc[R][4];
#pragma unroll
        for (int rr = 0; rr < R; ++rr)
#pragma unroll
            for (int nt = 0; nt < 4; ++nt) acc[rr][nt] = (f32x4_t){0.f, 0.f, 0.f, 0.f};
        const bf16_t* w1f = P.w1f + (size_t)slot * 64 * 4 * 512 + lane * 8;
#pragma unroll 4
        for (int ks = 0; ks < 64; ++ks) {
            bf16x8_t a[4];
#pragma unroll
            for (int nt = 0; nt < 4; ++nt) a[nt] = *(const bf16x8_t*)(w1f + (size_t)(ks * 4 + nt) * 512);
            const size_t off = (size_t)(ks >> 1) * stride + (ks & 1) * 32;
#pragma unroll
            for (int rr = 0; rr < R; ++rr) {
                const float4 x0 = *(const float4*)(rowp[rr] + off), x1 = *(const float4*)(rowp[rr] + off + 4);
                v4u t; t.x = pk2(x0.x, x0.y); t.y = pk2(x0.z, x0.w); t.z = pk2(x1.x, x1.y); t.w = pk2(x1.z, x1.w);
                const bf16x8_t bfr = __builtin_bit_cast(bf16x8_t, t);
#pragma unroll
                for (int nt = 0; nt < 4; ++nt) acc[rr][nt] = __builtin_amdgcn_mfma_f32_16x16x32_bf16(a[nt], bfr, acc[rr][nt], 0, 0, 0);
            }
        }
        const float* c1 = P.c1 + slot * 64 + 4 * kq;
        const bf16_t* w2f = P.w2f + (size_t)slot * 2 * 4 * 512 + lane * 8;
#pragma unroll
        for (int rr = 0; rr < R; ++rr) {
            bf16x8_t hb[2];
#pragma unroll
            for (int k2 = 0; k2 < 2; ++k2) { float hv[8];
#pragma unroll
                for (int j = 0; j < 8; ++j) { const int nt = 2 * k2 + (j >> 2); hv[j] = gelu_tanh(acc[rr][nt][j & 3] + c1[16 * nt + (j & 3)]); }
                v4u t; t.x = pk2(hv[0], hv[1]); t.y = pk2(hv[2], hv[3]); t.z = pk2(hv[4], hv[5]); t.w = pk2(hv[6], hv[7]); hb[k2] = __builtin_bit_cast(bf16x8_t, t); }
#pragma unroll
            for (int ft = 0; ft < 4; ++ft) { f32x4_t o2 = (f32x4_t){0.f, 0.f, 0.f, 0.f};
#pragma unroll
                for (int k2 = 0; k2 < 2; ++k2) o2 = __builtin_amdgcn_mfma_f32_16x16x32_bf16(*(const bf16x8_t*)(w2f + (size_t)(k2 * 4 + ft) * 512), hb[k2], o2, 0, 0, 0);
                const int oi = obase[rr] + 16 * ft + 4 * kq;
                uint2 w; w.x = pk2(o2[0], o2[1]); w.y = pk2(o2[2], o2[3]); *(uint2*)((slot ? P.vcb : P.kcb) + oi) = w; }
        }
    }
}
__device__ __forceinline__ void compress_sample_lds(const Ptrs& P, LAS unsigned char* L, int bid, int nblk, int wave, int lane, int tid) {
    constexpr int R = 2, NTASK = BS * 16 / R * 2;
    const int r16 = lane & 15, kq = lane >> 4, n4 = r16 >> 2, g = r16 & 3;
    for (int base = bid * 8; base < NTASK; base += nblk * 8) {
        const int task = base + wave; const bool valid = task < NTASK; const int tk = valid ? task : NTASK - 2 + (wave & 1);
        const int slot = tk & 1, pgp = tk >> 1;
        const float* rowp[R];
#pragma unroll
        for (int rr = 0; rr < R; ++rr) { const int pgi = pgp * R + rr, b = pgi >> 4, pg = pgi & 15; const int page = P.pt[b * 16 + pg];
            rowp[rr] = P.cache + ((size_t)page * 128 + n4 * 32) * 1024 + slot * 256 + g * 64 + 8 * kq; }
        f32x4_t acc[R][4];
#pragma unroll
        for (int rr = 0; rr < R; ++rr)
#pragma unroll
            for (int nt = 0; nt < 4; ++nt) acc[rr][nt] = (f32x4_t){0.f, 0.f, 0.f, 0.f};
        const bf16_t* wsrc0 = P.w1f + (size_t)tid * 8;
        v4u wr[4];
#pragma unroll
        for (int c = 0; c < 4; ++c) wr[c] = *(const v4u*)(wsrc0 + (size_t)((c >> 1) * 64) * 4 * 512 + (c & 1) * 4096);
        __syncthreads();
#pragma unroll
        for (int c = 0; c < 4; ++c) *(LAS v4u*)(L + (c >> 1) * 16384 + (c & 1) * 8192 + tid * 16) = wr[c];
        __syncthreads();
        for (int kb = 0; kb < 16; ++kb) {
            const int kn = (kb < 15) ? kb + 1 : kb;
#pragma unroll
            for (int c = 0; c < 4; ++c) wr[c] = *(const v4u*)(wsrc0 + (size_t)((c >> 1) * 64 + 4 * kn) * 4 * 512 + (c & 1) * 4096);
            float4 x[4][R][2];
#pragma unroll
            for (int q = 0; q < 4; ++q)
#pragma unroll
                for (int rr = 0; rr < R; ++rr) { const size_t off = (size_t)(2 * kb + (q >> 1)) * 1024 + (q & 1) * 32; x[q][rr][0] = *(const float4*)(rowp[rr] + off); x[q][rr][1] = *(const float4*)(rowp[rr] + off + 4); }
            const LAS unsigned char* wb = L + (kb & 1) * 32768 + slot * 16384 + lane * 16;
#pragma unroll
            for (int q = 0; q < 4; ++q) {
                bf16x8_t a[4];
#pragma unroll
                for (int nt = 0; nt < 4; ++nt) a[nt] = *(const LAS bf16x8_t*)(wb + (q * 4 + nt) * 1024);
#pragma unroll
                for (int rr = 0; rr < R; ++rr) {
                    const float4 x0 = x[q][rr][0], x1 = x[q][rr][1];
                    v4u t; t.x = pk2(x0.x, x0.y); t.y = pk2(x0.z, x0.w); t.z = pk2(x1.x, x1.y); t.w = pk2(x1.z, x1.w);
                    const bf16x8_t bfr = __builtin_bit_cast(bf16x8_t, t);
#pragma unroll
                    for (int nt = 0; nt < 4; ++nt) acc[rr][nt] = __builtin_amdgcn_mfma_f32_16x16x32_bf16(a[nt], bfr, acc[rr][nt], 0, 0, 0);
                }
            }
#pragma unroll
            for (int c = 0; c < 4; ++c) *(LAS v4u*)(L + ((kb + 1) & 1) * 32768 + (c >> 1) * 16384 + (c & 1) * 8192 + tid * 16) = wr[c];
            __syncthreads();
        }
        int l2; asm volatile("v_mbcnt_lo_u32_b32 %0, -1, 0\n\tv_mbcnt_hi_u32_b32 %0, -1, %0" : "=v"(l2) :: "memory");
        const int kq2 = l2 >> 4, r2 = l2 & 15;
        const float* c1 = P.c1 + slot * 64 + 4 * kq2;
        const bf16_t* w2f = P.w2f + (size_t)slot * 2 * 4 * 512 + l2 * 8;
#pragma unroll
        for (int rr = 0; rr < R; ++rr) {
            const int pgi = pgp * R + rr, b = pgi >> 4, pg = pgi & 15; const int ob = (((BP + b) * 64 + pg * 4 + (r2 >> 2)) * 4 + (r2 & 3)) * 64;
            bf16x8_t hb[2];
#pragma unroll
            for (int k2 = 0; k2 < 2; ++k2) { float hv[8];
#pragma unroll
                for (int j = 0; j < 8; ++j) { const int nt = 2 * k2 + (j >> 2); hv[j] = gelu_tanh(acc[rr][nt][j & 3] + c1[16 * nt + (j & 3)]); }
                v4u t; t.x = pk2(hv[0], hv[1]); t.y = pk2(hv[2], hv[3]); t.z = pk2(hv[4], hv[5]); t.w = pk2(hv[6], hv[7]); hb[k2] = __builtin_bit_cast(bf16x8_t, t); }
#pragma unroll
            for (int ft = 0; ft < 4; ++ft) { f32x4_t o2 = (f32x4_t){0.f, 0.f, 0.f, 0.f};
#pragma unroll
                for (int k2 = 0; k2 < 2; ++k2) o2 = __builtin_amdgcn_mfma_f32_16x16x32_bf16(*(const bf16x8_t*)(w2f + (size_t)(k2 * 4 + ft) * 512), hb[k2], o2, 0, 0, 0);
                const int oi = ob + 16 * ft + 4 * kq2;
                uint2 w; w.x = pk2(o2[0], o2[1]); w.y = pk2(o2[2], o2[3]); if (valid) *(uint2*)((slot ? P.vcb : P.kcb) + oi) = w; }
        }
    }
}
__device__ __forceinline__ void compress_prompt_split(const Ptrs& P, LAS unsigned char* L, int bid, int wave, int lane) {
    const int r16 = lane & 15, kq = lane >> 4, n4 = r16 >> 2, g = r16 & 3;
    const int task = bid * 4 + (wave >> 1), kh = wave & 1, slot = task & 1, pgi = task >> 1, b = pgi >> 4, pg = pgi & 15;
    const float* rowp = P.out + O_KVP + (size_t)(b * TP + pg * 128 + n4 * 32) * 1024 + slot * 256 + g * 64 + 8 * kq;
    f32x4_t acc[4];
#pragma unroll
    for (int nt = 0; nt < 4; ++nt) acc[nt] = (f32x4_t){0.f, 0.f, 0.f, 0.f};
    const bf16_t* w1f = P.w1f + (size_t)slot * 64 * 4 * 512 + lane * 8;
#pragma unroll 4
    for (int kk = 0; kk < 32; ++kk) { const int ks = 32 * kh + kk;
        bf16x8_t a[4];
#pragma unroll
        for (int nt = 0; nt < 4; ++nt) a[nt] = *(const bf16x8_t*)(w1f + (size_t)(ks * 4 + nt) * 512);
        const size_t off = (size_t)(ks >> 1) * 1024 + (ks & 1) * 32;
        const float4 x0 = *(const float4*)(rowp + off), x1 = *(const float4*)(rowp + off + 4);
        v4u t; t.x = pk2(x0.x, x0.y); t.y = pk2(x0.z, x0.w); t.z = pk2(x1.x, x1.y); t.w = pk2(x1.z, x1.w);
        const bf16x8_t bfr = __builtin_bit_cast(bf16x8_t, t);
#pragma unroll
        for (int nt = 0; nt < 4; ++nt) acc[nt] = __builtin_amdgcn_mfma_f32_16x16x32_bf16(a[nt], bfr, acc[nt], 0, 0, 0);
    }
    LAS f32x4_t* X = (LAS f32x4_t*)(L + (wave >> 1) * 4096) + lane;
    __syncthreads();
    if (kh == 1) {
#pragma unroll
        for (int nt = 0; nt < 4; ++nt) X[nt * 64] = acc[nt]; }
    __syncthreads();
    if (kh == 0) {
#pragma unroll
        for (int nt = 0; nt < 4; ++nt) acc[nt] += X[nt * 64];
        const float* c1 = P.c1 + slot * 64 + 4 * kq; const bf16_t* w2f = P.w2f + (size_t)slot * 2 * 4 * 512 + lane * 8;
        const int ob = (((b) * 64 + pg * 4 + n4) * 4 + g) * 64;
        bf16x8_t hb[2];
#pragma unroll
        for (int k2 = 0; k2 < 2; ++k2) { float hv[8];
#pragma unroll
            for (int j = 0; j < 8; ++j) { const int nt = 2 * k2 + (j >> 2); hv[j] = gelu_tanh(acc[nt][j & 3] + c1[16 * nt + (j & 3)]); }
            v4u t; t.x = pk2(hv[0], hv[1]); t.y = pk2(hv[2], hv[3]); t.z = pk2(hv[4], hv[5]); t.w = pk2(hv[6], hv[7]); hb[k2] = __builtin_bit_cast(bf16x8_t, t); }
#pragma unroll
        for (int ft = 0; ft < 4; ++ft) { f32x4_t o2 = (f32x4_t){0.f, 0.f, 0.f, 0.f};
#pragma unroll
            for (int k2 = 0; k2 < 2; ++k2) o2 = __builtin_amdgcn_mfma_f32_16x16x32_bf16(*(const bf16x8_t*)(w2f + (size_t)(k2 * 4 + ft) * 512), hb[k2], o2, 0, 0, 0);
            const int oi = ob + 16 * ft + 4 * kq;
            uint2 w; w.x = pk2(o2[0], o2[1]); w.y = pk2(o2[2], o2[3]); *(uint2*)((slot ? P.vcb : P.kcb) + oi) = w; }
    }
}
__device__ __forceinline__ void prologue_cmp(const Ptrs& P, size_t gtid, size_t nthr, int gwave, int nwaves, int lane) {
    for (size_t i = gtid; i < (size_t)2 * 64 * 4 * 64; i += nthr) { const int ln = (int)(i & 63), nt = (int)((i >> 6) & 3), ks = (int)((i >> 8) & 63), slot = (int)(i >> 14);
        const float* w1 = slot ? P.w1_v : P.w1_k; const int e = 16 * nt + (ln & 15), k0 = 32 * ks + 8 * (ln >> 4);
        v4u t; t.x = pk2(w1[(size_t)(k0 + 0) * 64 + e], w1[(size_t)(k0 + 1) * 64 + e]); t.y = pk2(w1[(size_t)(k0 + 2) * 64 + e], w1[(size_t)(k0 + 3) * 64 + e]);
        t.z = pk2(w1[(size_t)(k0 + 4) * 64 + e], w1[(size_t)(k0 + 5) * 64 + e]); t.w = pk2(w1[(size_t)(k0 + 6) * 64 + e], w1[(size_t)(k0 + 7) * 64 + e]);
        *(v4u*)(P.w1f + i * 8) = t; }
    for (size_t i = gtid; i < (size_t)2 * 2 * 4 * 64; i += nthr) { const int ln = (int)(i & 63), ft = (int)((i >> 6) & 3), k2 = (int)((i >> 8) & 1), slot = (int)(i >> 9);
        const float* w2 = slot ? P.w2_v : P.w2_k; const int f = 16 * ft + (ln & 15); float v[8];
#pragma unroll
        for (int j = 0; j < 8; ++j) v[j] = w2[(size_t)(16 * (2 * k2 + (j >> 2)) + 4 * (ln >> 4) + (j & 3)) * 64 + f];
        v4u t; t.x = pk2(v[0], v[1]); t.y = pk2(v[2], v[3]); t.z = pk2(v[4], v[5]); t.w = pk2(v[6], v[7]); *(v4u*)(P.w2f + i * 8) = t; }
    { const int nblk_ = nwaves >> 3, bid_ = gwave >> 3, wv_ = gwave & 7;
      for (int it = wv_ * nblk_ + bid_; it < 128; it += nwaves) { const int slot = it >> 6, e = it & 63; const float* w1 = slot ? P.w1_v : P.w1_k; const float* pe = slot ? P.pe_v : P.pe_k;
        float sacc = 0.f;
        for (int k0 = 0; k0 < 2048; k0 += 512) { float pv[8], wv[8];
#pragma unroll
            for (int i = 0; i < 8; ++i) { const int k = k0 + 64 * i + lane; pv[i] = pe[k]; wv[i] = w1[(size_t)k * 64 + e]; }
#pragma unroll
            for (int i = 0; i < 8; ++i) sacc = fmaf(pv[i], wv[i], sacc); }
        sacc = wave_sum(sacc); if (lane == 0) P.c1[it] = sacc; } }
}
typedef float f32x16_t __attribute__((ext_vector_type(16)));
typedef short v4i16_t __attribute__((ext_vector_type(4)));
constexpr float LOG2E = 1.4426950408889634f;
constexpr float QSCALE = 0.125f * LOG2E;
constexpr int A_K0 = 0, A_V0 = 8192, A_K1 = 16384, A_V1 = 24576, A_BT = 32768, A_SEL = 34816, A_UNION = 35072, A_IMP = 36864, A_RB = A_IMP + 4 * 64 * 32 * 4, A_END = A_RB + 4 * 4 * 256 * 4;
__device__ __forceinline__ int crow(int r, int hi) { return (r & 3) + 8 * (r >> 2) + 4 * hi; }
__device__ __forceinline__ unsigned cvtpk(float lo, float hi) { unsigned r; asm volatile("v_cvt_pk_bf16_f32 %0, %1, %2" : "=v"(r) : "v"(lo), "v"(hi)); return r; }

__device__ __forceinline__ void qk_tile(f32x16_t& s0, f32x16_t& s1, const LAS unsigned char* kb, const bf16x8_t (&qf)[4], int r32, int hi, float init = 0.f) {
#pragma unroll
    for (int r = 0; r < 16; ++r) { s0[r] = init; s1[r] = init; }
#pragma unroll
    for (int d0 = 0; d0 < 4; ++d0) {
        const int c = 2 * d0 + hi;
        const bf16x8_t a0 = *(const LAS bf16x8_t*)(kb + c * 1024 + ((r32 ^ c) * 16));
        const bf16x8_t a1 = *(const LAS bf16x8_t*)(kb + c * 1024 + 512 + ((r32 ^ c) * 16));
        s0 = __builtin_amdgcn_mfma_f32_32x32x16_bf16(a0, qf[d0], s0, 0, 0, 0);
        s1 = __builtin_amdgcn_mfma_f32_32x32x16_bf16(a1, qf[d0], s1, 0, 0, 0);
    }
}
__device__ __forceinline__ void pv_tile(f32x16_t (&o)[2], const LAS unsigned char* vb, const f32x16_t& p0, const f32x16_t& p1, int lane) {
    bf16x8_t pf[4];
#pragma unroll
    for (int s = 0; s < 4; ++s) {
        const int base = 8 * (s & 1);
        unsigned w[4];
#pragma unroll
        for (int k = 0; k < 4; ++k) w[k] = (s < 2) ? cvtpk(p0[base + 2 * k], p0[base + 2 * k + 1]) : cvtpk(p1[base + 2 * k], p1[base + 2 * k + 1]);
        v4u t; t.x = w[0]; t.y = w[1]; t.z = w[2]; t.w = w[3]; pf[s] = __builtin_bit_cast(bf16x8_t, t);
    }
    const LAS unsigned char* va = vb + ((lane >> 4) & 1) * 32 + (lane & 3) * 8 + (4 * (lane >> 5) + ((lane & 15) >> 2)) * 64;
#pragma unroll
    for (int dd = 0; dd < 2; ++dd)
#pragma unroll
        for (int s = 0; s < 4; ++s) {
            const v4i16_t lo = __builtin_amdgcn_ds_read_tr16_b64_v4i16((LAS v4i16_t*)(va + dd * 4096 + s * 1024));
            const v4i16_t hh = __builtin_amdgcn_ds_read_tr16_b64_v4i16((LAS v4i16_t*)(va + dd * 4096 + s * 1024 + 512));
            const bf16x8_t vf = (bf16x8_t){lo[0], lo[1], lo[2], lo[3], hh[0], hh[1], hh[2], hh[3]};
            o[dd] = __builtin_amdgcn_mfma_f32_32x32x16_bf16(vf, pf[s], o[dd], 0, 0, 0);
        }
}
__device__ __forceinline__ v4u ld_k16(const bf16_t* src, int stride, int wave, int lane) { const int t = wave * 64 + lane; return *(const v4u*)(src + (size_t)(t >> 3) * stride + (t & 7) * 8); }
__device__ __forceinline__ v4u ld_v16(const bf16_t* src, int stride, int tid) { return *(const v4u*)(src + (size_t)(tid >> 3) * stride + (tid & 7) * 8); }
__device__ __forceinline__ void st_k16(LAS unsigned char* kb, v4u v, int wave, int lane) { const int t = wave * 64 + lane, key = t >> 3, c = t & 7; *(LAS v4u*)(kb + c * 1024 + ((key ^ c) * 16)) = v; }
__device__ __forceinline__ void st_v16(LAS unsigned char* vb, v4u v, int tid) { const int key = tid >> 3, c = tid & 7; *(LAS v4u*)(vb + (c >> 2) * 4096 + (key >> 3) * 512 + (key & 7) * 64 + (c & 3) * 16) = v; }

__device__ __forceinline__ float half_max(float v) { const auto rr = __builtin_amdgcn_permlane32_swap(__builtin_bit_cast(unsigned, v), __builtin_bit_cast(unsigned, v), false, false); return fmaxf(__builtin_bit_cast(float, (unsigned)rr[0]), __builtin_bit_cast(float, (unsigned)rr[1])); }
__device__ __forceinline__ float half_sum(float v) { const auto rr = __builtin_amdgcn_permlane32_swap(__builtin_bit_cast(unsigned, v), __builtin_bit_cast(unsigned, v), false, false); return __builtin_bit_cast(float, (unsigned)rr[0]) + __builtin_bit_cast(float, (unsigned)rr[1]); }

typedef float f32x2_t __attribute__((ext_vector_type(2)));
__device__ __forceinline__ f32x2_t pk_sub(f32x2_t a, f32x2_t b) { f32x2_t r; asm("v_pk_add_f32 %0, %1, %2 neg_lo:[0,1] neg_hi:[0,1]" : "=v"(r) : "v"(a), "v"(b)); return r; }
__device__ __forceinline__ float max3f(float a, float b, float c) { float r; asm("v_max3_f32 %0, %1, %2, %3" : "=v"(r) : "v"(a), "v"(b), "v"(c)); return r; }
__device__ __forceinline__ void softmax_pv(f32x16_t& s0, f32x16_t& s1, float& m_run, float& l_run, f32x16_t (&o)[2], const LAS unsigned char* vb, int lane, float tbias = 0.f) {
    float tm = -INFINITY, tm2 = -INFINITY;
#pragma unroll
    for (int r = 0; r < 16; r += 2) { tm = max3f(tm, s0[r], s1[r]); tm2 = max3f(tm2, s0[r + 1], s1[r + 1]); }
    tm = half_max(max3f(tm, tm2, tm2)) + tbias;
    const float m_new = fmaxf(m_run, tm);
    const float m_use = (m_new == -INFINITY) ? 0.f : m_new;
    const float alpha = __builtin_amdgcn_exp2f(m_run - m_use);
    { const float ms = m_use - tbias; const f32x2_t mm = {ms, ms};
#pragma unroll
      for (int r = 0; r < 16; r += 2) { const f32x2_t d0 = pk_sub(f32x2_t{s0[r], s0[r + 1]}, mm), d1 = pk_sub(f32x2_t{s1[r], s1[r + 1]}, mm);
          s0[r] = __builtin_amdgcn_exp2f(d0[0]); s0[r + 1] = __builtin_amdgcn_exp2f(d0[1]); s1[r] = __builtin_amdgcn_exp2f(d1[0]); s1[r + 1] = __builtin_amdgcn_exp2f(d1[1]); } }
    float rs;
    { typedef float f32x8_t __attribute__((ext_vector_type(8)));
      const f32x16_t ps = s0 + s1;
      const f32x8_t a8 = __builtin_shufflevector(ps, ps, 0, 1, 2, 3, 4, 5, 6, 7) + __builtin_shufflevector(ps, ps, 8, 9, 10, 11, 12, 13, 14, 15);
      const f32x4_t a4 = __builtin_shufflevector(a8, a8, 0, 1, 2, 3) + __builtin_shufflevector(a8, a8, 4, 5, 6, 7);
      const f32x2_t a2 = __builtin_shufflevector(a4, a4, 0, 1) + __builtin_shufflevector(a4, a4, 2, 3);
      rs = a2[0] + a2[1]; }
    rs = half_sum(rs);
    l_run = l_run * alpha + rs; m_run = m_new;
    if (__any(alpha != 1.0f)) {
#pragma unroll
        for (int r = 0; r < 16; ++r) { o[0][r] *= alpha; o[1][r] *= alpha; } }
    pv_tile(o, vb, s0, s1, lane);
}

__device__ __forceinline__ void attn_prompt_unit(const Ptrs& P, LAS unsigned char* L, int b, int g, int qb, int tid_param, bool fill) {
    const int tid_in = tid_param;
    const int wave = __builtin_amdgcn_readfirstlane(tid_in >> 6), hh = wave >> 1, th = wave & 1, m0 = b * TP + 64 * qb, h = g * 4 + hh;
    bf16x8_t qf[4]; f32x16_t oacc[2], o[2], s0, s1;
    {
    int tid = tid_in; asm volatile("" : "+v"(tid));
    const int lane = tid & 63, r32 = lane & 31, hi = lane >> 5;
    const int tl = 32 * th + r32, t = 64 * qb + tl;
    LAS float* BT = (LAS float*)(L + A_BT); LAS unsigned* SEL = (LAS unsigned*)(L + A_SEL); LAS unsigned* UNI = (LAS unsigned*)(L + A_UNION); LAS float* IMP = (LAS float*)(L + A_IMP);
    const float NEG = -INFINITY;
    __syncthreads();
    if (fill) BT[tid] = P.rel_bias[BUCKET[tid & 127] * 16 + g * 4 + (tid >> 7)] * LOG2E;
    if (fill) { LAS float* RB = (LAS float*)(L + A_RB);
#pragma unroll 2
      for (int k = 0; k < 8; ++k) { const int e = tid + 512 * k, z = e & 255, a = (e >> 8) & 3, hd = e >> 10; const int d = 191 - (z + a);
          RB[e] = (d < 0) ? -INFINITY : P.rel_bias[BUCKET[d > 127 ? 127 : d] * 16 + g * 4 + hd] * LOG2E; } }
    if (tid == 0) UNI[0] = 0u;
#pragma unroll
    for (int d0 = 0; d0 < 4; ++d0) qf[d0] = *(const bf16x8_t*)(P.qb + (size_t)(m0 + tl) * 1024 + h * 64 + 16 * d0 + 8 * hi);
    const float g0 = P.ngs[(size_t)(m0 + tl) * 48 + h];
    {
        const bf16_t* ksrc = P.kcb + ((size_t)b * 64 * 4 + g) * 64; const bf16_t* vsrc = P.vcb + ((size_t)b * 64 * 4 + g) * 64;
        st_k16(L + A_K0, ld_k16(ksrc, 256, wave, lane), wave, lane); st_v16(L + A_V0, ld_v16(vsrc, 256, tid), tid);
        __syncthreads();
        qk_tile(s0, s1, L + A_K0, qf, r32, hi);
#pragma unroll
        for (int r = 0; r < 16; ++r) { const int i0 = crow(r, hi); const int d0 = t - 32 * i0 - 31, d1 = d0 - 1024;
            s0[r] = (d0 >= 0) ? s0[r] + BT[hh * 128 + (d0 > 127 ? 127 : d0)] : NEG;
            s1[r] = (d1 >= 0) ? s1[r] + BT[hh * 128 + (d1 > 127 ? 127 : d1)] : NEG; }
        float m_run = NEG, l_run = 0.f;
#pragma unroll
        for (int r = 0; r < 16; ++r) { o[0][r] = 0.f; o[1][r] = 0.f; }
        softmax_pv(s0, s1, m_run, l_run, o, L + A_V0, lane);
        const float inv = l_run > 0.f ? 1.0f / l_run : 0.f;
#pragma unroll
        for (int r = 0; r < 16; r += 2) { const int sb = crow(r, hi) >> 1;
            IMP[(hh * 64 + tl) * 32 + sb] = (s0[r] + s0[r + 1]) * inv; IMP[(hh * 64 + tl) * 32 + 16 + sb] = (s1[r] + s1[r + 1]) * inv; }
        const float sc = g0 * inv;
#pragma unroll
        for (int r = 0; r < 16; ++r) { oacc[0][r] = o[0][r] * sc; oacc[1][r] = o[1][r] * sc; }
    }
    __syncthreads();
    {
        const int tk = tid >> 3, sub = tid & 7; unsigned bits = 0u;
        if (qb + 1 <= 16) { bits = (sub == 0) ? ((1u << (qb + 1)) - 1u) : 0u; }
        else {
            float imp[32];
#pragma unroll
            for (int j = 0; j < 32; ++j) imp[j] = IMP[(0 * 64 + tk) * 32 + j] + IMP[(1 * 64 + tk) * 32 + j] + IMP[(2 * 64 + tk) * 32 + j] + IMP[(3 * 64 + tk) * 32 + j];
#pragma unroll
            for (int q4 = 0; q4 < 4; ++q4) {
                float mine = 0.f;
#pragma unroll
                for (int j = 0; j < 32; ++j) mine = (j == (sub * 4 + q4)) ? imp[j] : mine;
                const int sb = sub * 4 + q4;
                const bool forced = (sb == 0) || (sb == qb) || (sb == qb - 1); const bool cand = (sb >= 1) && (sb <= qb - 2);
                int rank = 0;
#pragma unroll
                for (int j = 1; j < 32; ++j) rank += (j <= qb - 2 && (imp[j] > mine || (imp[j] == mine && j < sb))) ? 1 : 0;
                if (forced || (cand && rank < 13)) bits |= 1u << sb;
            }
        }
        bits |= __shfl_xor(bits, 1); bits |= __shfl_xor(bits, 2); bits |= __shfl_xor(bits, 4);
        if (sub == 0) { SEL[tk] = bits; __hip_atomic_fetch_or(UNI, bits, __ATOMIC_RELAXED, __HIP_MEMORY_SCOPE_WORKGROUP); }
    }
    }
    __syncthreads();
    int tid = tid_in; asm volatile("" : "+v"(tid));
    const int lane = tid & 63, r32 = lane & 31, hi = lane >> 5, tl = 32 * th + r32;
    LAS float* BT = (LAS float*)(L + A_BT); LAS unsigned* SEL = (LAS unsigned*)(L + A_SEL); LAS unsigned* UNI = (LAS unsigned*)(L + A_UNION);
    const float NEG = -INFINITY;
    unsigned rem = UNI[0]; const unsigned selbits = SEL[tl];
    int wj = qb - (qb < 8 ? qb : 8);
    const bf16_t* ksel = P.kvb + ((size_t)0 * M + (size_t)b * TP) * 256 + g * 64; const bf16_t* vsel = P.kvb + ((size_t)1 * M + (size_t)b * TP) * 256 + g * 64;
    const bf16_t* kwin = P.kvb + ((size_t)2 * M + (size_t)b * TP) * 256 + g * 64; const bf16_t* vwin = P.kvb + ((size_t)3 * M + (size_t)b * TP) * 256 + g * 64;
    int ckind, cj, nkind, nj;
    { ckind = 0; cj = __builtin_ctz(rem); rem &= rem - 1u; }
    st_k16(L + A_K0, ld_k16(ksel + (size_t)cj * 64 * 256, 256, wave, lane), wave, lane); st_v16(L + A_V0, ld_v16(vsel + (size_t)cj * 64 * 256, 256, tid), tid);
#define PA_POP(K_, J_) { if (rem) { K_ = 0; J_ = __builtin_ctz(rem); rem &= rem - 1u; } else if (wj <= qb) { K_ = 1; J_ = wj; ++wj; } else { K_ = -1; J_ = 0; } }
#define PA_LOAD(KR_, VR_, K_, J_) { if ((K_) >= 0) { KR_ = ld_k16(((K_) ? kwin : ksel) + (size_t)(J_) * 64 * 256, 256, wave, lane); VR_ = ld_v16(((K_) ? vwin : vsel) + (size_t)(J_) * 64 * 256, 256, tid); } }
    int n2kind, n2j;
    PA_POP(nkind, nj)
    v4u kreg = {0u, 0u, 0u, 0u}, vreg = {0u, 0u, 0u, 0u};
    PA_LOAD(kreg, vreg, nkind, nj)
    __syncthreads();
    float m_run = NEG, l_run = 0.f;
#pragma unroll
    for (int r = 0; r < 16; ++r) { o[0][r] = 0.f; o[1][r] = 0.f; }
    int buf = 0;
    for (;;) {
        PA_POP(n2kind, n2j)
        v4u kreg2 = {0u, 0u, 0u, 0u}, vreg2 = {0u, 0u, 0u, 0u};
        PA_LOAD(kreg2, vreg2, n2kind, n2j)
        const LAS unsigned char* kb = L + (buf ? A_K1 : A_K0); const LAS unsigned char* vb = L + (buf ? A_V1 : A_V0);
        const int dj = qb - cj;
        const int dbase = 64 * dj + tl;
        qk_tile(s0, s1, kb, qf, r32, hi);
        const float tbias = (ckind == 0 && ((selbits >> cj) & 1u) == 0u) ? NEG : (dj <= 2 ? 0.f : BT[hh * 128 + 127]);
        if (dj <= 2) {
            const int y0 = 191 - dbase + 4 * hi, a = y0 & 3;
            const LAS f32x4_t* rb = (const LAS f32x4_t*)(L + A_RB) + (((hh * 4 + a) * 256 + (y0 - a)) >> 2);
#pragma unroll
            for (int gq = 0; gq < 4; ++gq) { const f32x4_t b0 = rb[2 * gq], b1 = rb[2 * gq + 8];
#pragma unroll
                for (int j = 0; j < 4; ++j) { s0[4 * gq + j] += b0[j]; s1[4 * gq + j] += b1[j]; } }
        } else {
            if (ckind == 1 && dj == 8) {
#pragma unroll
                for (int r = 0; r < 16; ++r) { const int k0 = crow(r, hi); const int d0 = dbase - k0, d1 = d0 - 32; if (d0 > 512) s0[r] = NEG; if (d1 > 512) s1[r] = NEG; }
            }
        }
        softmax_pv(s0, s1, m_run, l_run, o, vb, lane, tbias);
        if (nkind >= 0) { st_k16(L + (buf ? A_K0 : A_K1), kreg, wave, lane); st_v16(L + (buf ? A_V0 : A_V1), vreg, tid); }
        __syncthreads();
        if (ckind == 0 && nkind != 0) {
            const float sc = P.ngs[(size_t)(m0 + tl) * 48 + 16 + h] * (l_run > 0.f ? 1.0f / l_run : 0.f);
#pragma unroll
            for (int r = 0; r < 16; ++r) { oacc[0][r] += o[0][r] * sc; oacc[1][r] += o[1][r] * sc; o[0][r] = 0.f; o[1][r] = 0.f; }
            m_run = NEG; l_run = 0.f;
        }
        if (nkind < 0) break;
        ckind = nkind; cj = nj; nkind = n2kind; nj = n2j; kreg = kreg2; vreg = vreg2; buf ^= 1;
    }
#undef PA_POP
#undef PA_LOAD
    {
        const float sc = P.ngs[(size_t)(m0 + tl) * 48 + 32 + h] * (l_run > 0.f ? 1.0f / l_run : 0.f);
#pragma unroll
        for (int r = 0; r < 16; ++r) { oacc[0][r] += o[0][r] * sc; oacc[1][r] += o[1][r] * sc; }
    }
    bf16_t* orow = P.xcat + (size_t)(m0 + tl) * D + 1024 + h * 64;
#pragma unroll
    for (int dd = 0; dd < 2; ++dd)
#pragma unroll
        for (int gq = 0; gq < 4; ++gq) { uint2 w; w.x = cvtpk(oacc[dd][4 * gq], oacc[dd][4 * gq + 1]); w.y = cvtpk(oacc[dd][4 * gq + 2], oacc[dd][4 * gq + 3]);
            *(uint2*)(orow + 32 * dd + 8 * gq + 4 * hi) = w; }
}
__device__ __forceinline__ void attn_prompt_stage(const Ptrs& P, LAS unsigned char* L, int bid, int nblk, int tid) {
    for (int pi = bid; pi < 256; pi += nblk) {
        const int bg = pi >> 4, s = pi & 15;
        for (int u = 0; u < 2; ++u) attn_prompt_unit(P, L, bg >> 2, bg & 3, u ? 31 - s : s, tid, u == 0);
    }
}

constexpr int S_BT = 131072 + 1024, S_IMP = S_BT + 2048, S_PC = 131072 + 8192, S_Q = S_PC + 4096;
__device__ __forceinline__ v4u pack8(const float4 a, const float4 b) { v4u t; t.x = pk2(a.x, a.y); t.y = pk2(a.z, a.w); t.z = pk2(b.x, b.y); t.w = pk2(b.z, b.w); return t; }
struct Rows16 { float4 r[16]; };
__device__ __forceinline__ void rows_load(Rows16& T, const float* base, int stride, int nvalid, int lane) {
    const float* p = base + (size_t)(lane >> 4) * stride + 4 * (lane & 15); const size_t inc = (size_t)4 * stride; (void)nvalid;
#pragma unroll
    for (int i = 0; i < 16; ++i) { T.r[i] = *(const float4*)p; p += inc; }
}
__device__ __forceinline__ void rows_store(const Rows16& T, float* dst, bool first, int lane) {
    float* p = dst + (size_t)(lane >> 4) * 512 + 4 * (lane & 15);
    if (!first) *(float4*)p = T.r[0];
#pragma unroll
    for (int i = 1; i < 16; ++i) *(float4*)(p + (size_t)i * 2048) = T.r[i];
}
typedef unsigned v2u __attribute__((ext_vector_type(2)));
__device__ __forceinline__ v2u pack4(const float4 a) { v2u t; t.x = pk2(a.x, a.y); t.y = pk2(a.z, a.w); return t; }
__device__ __forceinline__ void rows_stage_k(LAS unsigned char* kb, const Rows16& T, int nvalid, int lane) {
    const int q = lane >> 4, dc = lane & 15, c = dc >> 1, p = dc & 1; const bool part = nvalid < 64;
    LAS unsigned char* be = kb + c * 1024 + ((q ^ c) * 16) + p * 8;
    LAS unsigned char* bo = kb + c * 1024 + (((q ^ c) ^ 4) * 16) + p * 8;
#pragma unroll
    for (int i = 0; i < 16; ++i) { float4 a = T.r[i]; if (i > 0 && part) a = make_float4(0.f, 0.f, 0.f, 0.f);
        *(LAS v2u*)(((i & 1) ? bo : be) + 128 * (i >> 1)) = pack4(a); }
}
__device__ __forceinline__ void rows_stage_v(LAS unsigned char* vb, const Rows16& T, int nvalid, int lane) {
    const int q = lane >> 4, dc = lane & 15; const bool part = nvalid < 64;
    LAS unsigned char* b0 = vb + (dc >> 3) * 4096 + q * 64 + (dc & 7) * 8;
#pragma unroll
    for (int i = 0; i < 16; ++i) { float4 a = T.r[i]; if (i > 0 && part) a = make_float4(0.f, 0.f, 0.f, 0.f);
        *(LAS v2u*)(b0 + (i >> 1) * 512 + (i & 1) * 256) = pack4(a); }
}
__device__ __forceinline__ void attn_sample_unit(const Ptrs& P, LAS unsigned char* L, int b, int g, int tid) {
    const int lane = tid & 63, wave = __builtin_amdgcn_readfirstlane(tid >> 6), r32 = lane & 31, hi = lane >> 5, q = r32 & 15, tok = q >> 2, hh = q & 3, h = g * 4 + hh;
    LAS float* BT = (LAS float*)(L + S_BT); LAS float* IMP = (LAS float*)(L + S_IMP + wave * 512);
    LAS unsigned char* KB = L + wave * 16384; LAS unsigned char* VB = KB + 8192;
    const float NEG = -INFINITY; const int mrow = MP + b * TS + tok;
    __syncthreads();
    BT[tid] = P.rel_bias[BUCKET[tid & 127] * 16 + g * 4 + (tid >> 7)] * LOG2E;
    bf16x8_t qf[4];
#pragma unroll
    for (int d0 = 0; d0 < 4; ++d0) qf[d0] = *(const bf16x8_t*)(P.qb + (size_t)mrow * 1024 + h * 64 + 16 * d0 + 8 * hi);
    { const bf16_t* ksrc = P.kcb + ((size_t)((BP + b) * 64 + lane) * 4 + g) * 64; const bf16_t* vsrc = P.vcb + ((size_t)((BP + b) * 64 + lane) * 4 + g) * 64;
#pragma unroll
      for (int c = 0; c < 8; ++c) { *(LAS v4u*)(KB + c * 1024 + ((lane ^ c) * 16)) = *(const v4u*)(ksrc + 8 * c);
          *(LAS v4u*)(VB + (c >> 2) * 4096 + (lane >> 3) * 512 + (lane & 7) * 64 + (c & 3) * 16) = *(const v4u*)(vsrc + 8 * c); } }
    if (wave == 0) {
#pragma unroll
        for (int d0 = 0; d0 < 4; ++d0) *(LAS bf16x8_t*)(L + S_Q + ((d0 * 2 + hi) * 32 + r32) * 16) = qf[d0]; }
    __syncthreads();
    f32x16_t s0, s1, o[2];
    float m_run = NEG, l_run = 0.f;
#pragma unroll
    for (int r = 0; r < 16; ++r) { o[0][r] = 0.f; o[1][r] = 0.f; }
    unsigned selbits = 0u, uni = 0u;
    if (wave < 6) {
    qk_tile(s0, s1, KB, qf, r32, hi);
#pragma unroll
    for (int r = 0; r < 16; ++r) { const int i0 = crow(r, hi); const int d0 = PAST + tok - 32 * i0 - 31, d1 = d0 - 1024;
        s0[r] += BT[hh * 128 + (d0 > 127 ? 127 : d0)]; s1[r] += BT[hh * 128 + (d1 > 127 ? 127 : d1)]; }
    softmax_pv(s0, s1, m_run, l_run, o, VB, lane);
    const float inv = 1.0f / l_run;
#pragma unroll
    for (int r = 0; r < 16; r += 2) { float a = (s0[r] + s0[r + 1]) * inv, c = (s1[r] + s1[r + 1]) * inv;
        a += __shfl_xor(a, 1); a += __shfl_xor(a, 2); c += __shfl_xor(c, 1); c += __shfl_xor(c, 2);
        if (hh == 0 && r32 < 16) { const int sb = crow(r, hi) >> 1; IMP[tok * 32 + sb] = a; IMP[tok * 32 + 16 + sb] = c; } }
    if (wave == 0 && r32 < 16) { LAS float* PC = (LAS float*)(L + S_PC) + q * 64;
#pragma unroll
        for (int dd = 0; dd < 2; ++dd)
#pragma unroll
            for (int r = 0; r < 16; ++r) PC[32 * dd + crow(r, hi)] = o[dd][r] * inv; }
    asm volatile("s_waitcnt lgkmcnt(0)" ::: "memory");
    { const int tk = lane >> 4, sp = lane & 15; unsigned bits = 0u;
      float imp[32];
#pragma unroll
      for (int q4 = 0; q4 < 8; ++q4) { const f32x4_t v = *(const LAS f32x4_t*)(IMP + tk * 32 + 4 * q4); imp[4 * q4] = v[0]; imp[4 * q4 + 1] = v[1]; imp[4 * q4 + 2] = v[2]; imp[4 * q4 + 3] = v[3]; }
#pragma unroll
      for (int i = 0; i < 2; ++i) { const int sb = 2 * sp + i; const float mine = IMP[tk * 32 + sb]; int rank = 0;
#pragma unroll
          for (int j = 1; j <= 30; ++j) { const float v = imp[j]; rank += (v > mine || (v == mine && j < sb)) ? 1 : 0; }
          const bool forced = (sb == 0) || (sb == 31); const bool cand = (sb >= 1) && (sb <= 30);
          if (forced || (cand && rank < 13)) bits |= 1u << sb; }
      bits |= __shfl_xor(bits, 1); bits |= __shfl_xor(bits, 2); bits |= __shfl_xor(bits, 4); bits |= __shfl_xor(bits, 8);
      selbits = __shfl(bits, tok * 16);
      uni = (unsigned)(__builtin_amdgcn_readlane((int)bits, 0) | __builtin_amdgcn_readlane((int)bits, 16) | __builtin_amdgcn_readlane((int)bits, 32) | __builtin_amdgcn_readlane((int)bits, 48)); }
    }
    m_run = NEG; l_run = 0.f;
#pragma unroll
    for (int r = 0; r < 16; ++r) { o[0][r] = 0.f; o[1][r] = 0.f; }
    const bool is_sel = wave < 6; const int first = is_sel ? wave : wave - 6, step = is_sel ? 6 : 2;
    unsigned long long rem = is_sel ? ((unsigned long long)uni | (1ull << 32)) : 0x1FFull;
    for (int k = 0; k < first; ++k) rem &= rem - 1ull;
#define TILE_POP(J_) { if (rem) { J_ = __builtin_ctzll(rem); for (int k_ = 0; k_ < step; ++k_) rem &= rem - 1ull; } else J_ = -1; }
#define SRC_TILE(jj, KB_, ST_, NV_) { const bool nk_ = is_sel ? ((jj) == 32) : ((jj) == 8); \
        if (nk_) { NV_ = TS; if (is_sel) { KB_ = P.out + O_KVS + (size_t)(b * TS) * 1024 + 512 + g * 64; ST_ = 1024; } else { KB_ = P.out + O_WINS + ((size_t)(b * 512 + 508) * 2) * 256 + g * 64; ST_ = 512; } } \
        else if (is_sel) { const int pos0 = 64 * (jj); const int page = P.pt[b * 16 + (pos0 >> 7)]; KB_ = P.cache + (((size_t)page * 128 + (pos0 & 127)) * 4 + 2) * 256 + g * 64; ST_ = 1024; NV_ = 64; } \
        else { KB_ = P.swin + ((size_t)(b * 512 + 64 * (jj)) * 2) * 256 + g * 64; ST_ = 512; NV_ = 64; } }
    Rows16 KR, VR;
    int j; TILE_POP(j);
    if (j >= 0) { const float* kb0; int st0, nv0; SRC_TILE(j, kb0, st0, nv0); rows_load(KR, kb0, st0, nv0, lane); }
    while (j >= 0) {
        int jnext; TILE_POP(jnext);
        const float* kbc; int stc, nvc; SRC_TILE(j, kbc, stc, nvc);
        rows_stage_k(KB, KR, nvc, lane);
        const bool wcopy = !is_sel && j < 8; float* wdst = P.out + O_WINS + ((size_t)(b * 512 + 64 * j) - 4) * 512 + g * 64;
        if (wcopy) rows_store(KR, wdst, j == 0, lane);
        rows_load(VR, kbc + 256, stc, nvc, lane);
        bf16x8_t qt[4];
#pragma unroll
        for (int d0 = 0; d0 < 4; ++d0) qt[d0] = *(const LAS bf16x8_t*)(L + S_Q + ((d0 * 2 + hi) * 32 + r32) * 16);
        asm volatile("s_waitcnt lgkmcnt(0)" ::: "memory");
        const int tb = is_sel ? (PAST - 64 * j) : (512 - 64 * j);
        const int dbase = tb + tok;
        qk_tile(s0, s1, KB, qt, r32, hi);
        const float tbias = (is_sel && j < 32 && ((selbits >> j) & 1u) == 0u) ? NEG : (tb <= 128 ? 0.f : BT[hh * 128 + 127]);
        if (tb <= 128) {
#pragma unroll
            for (int r = 0; r < 16; ++r) { const int k0 = crow(r, hi); const int d0 = dbase - k0, d1 = d0 - 32;
                const float b0 = BT[hh * 128 + (d0 > 127 ? 127 : (d0 < 0 ? 0 : d0))], b1 = BT[hh * 128 + (d1 > 127 ? 127 : (d1 < 0 ? 0 : d1))];
                s0[r] = (d0 >= 0) ? s0[r] + b0 : NEG; s1[r] = (d1 >= 0) ? s1[r] + b1 : NEG; }
        } else {
            if (!is_sel && tb == 512) {
#pragma unroll
                for (int r = 0; r < 16; ++r) { const int k0 = crow(r, hi); const int d0 = dbase - k0, d1 = d0 - 32; if (d0 > 512) s0[r] = NEG; if (d1 > 512) s1[r] = NEG; }
            }
        }
        rows_stage_v(VB, VR, nvc, lane);
        if (wcopy) rows_store(VR, wdst + 256, j == 0, lane);
        asm volatile("" ::: "memory");
        { const int jn = (jnext >= 0) ? jnext : j; const float* kbn; int stn, nvn; SRC_TILE(jn, kbn, stn, nvn); rows_load(KR, kbn, stn, nvn, lane); }
        asm volatile("s_waitcnt lgkmcnt(0)" ::: "memory");
        softmax_pv(s0, s1, m_run, l_run, o, VB, lane, tbias);
        asm volatile("s_waitcnt lgkmcnt(0)" ::: "memory");
        j = jnext;
    }
#undef SRC_TILE
#undef TILE_POP
    int l2; asm volatile("v_mbcnt_lo_u32_b32 %0, -1, 0\n\tv_mbcnt_hi_u32_b32 %0, -1, %0" : "=v"(l2));
    if ((l2 & 31) < 16) {
        const int q2 = l2 & 15, hi2 = l2 >> 5;
        LAS float* PO = (LAS float*)KB + q2 * 64;
#pragma unroll
        for (int dd = 0; dd < 2; ++dd)
#pragma unroll
            for (int r = 0; r < 16; ++r) PO[32 * dd + crow(r, hi2)] = o[dd][r];
        if (hi2 == 0) { LAS float* PM = (LAS float*)(KB + 4096); PM[2 * q2] = m_run; PM[2 * q2 + 1] = l_run; }
    }
    __syncthreads();
    {
        const int tid2 = wave * 64 + l2;
        const int cq = tid2 >> 5, cd = 2 * (tid2 & 31), ct = cq >> 2, ch = g * 4 + (cq & 3);
        float msel = NEG, mwin = NEG;
#pragma unroll
        for (int w = 0; w < 8; ++w) { const float mw = ((LAS float*)(L + w * 16384 + 4096))[2 * cq]; if (w < 6) msel = fmaxf(msel, mw); else mwin = fmaxf(mwin, mw); }
        float lsel = 0.f, lwin = 0.f, os0 = 0.f, os1 = 0.f, ow0 = 0.f, ow1 = 0.f;
#pragma unroll
        for (int w = 0; w < 8; ++w) { const LAS float* PM = (LAS float*)(L + w * 16384 + 4096); const LAS float* PO = (LAS float*)(L + w * 16384) + cq * 64 + cd;
            const float mw = PM[2 * cq], lw = PM[2 * cq + 1]; const float f = __builtin_amdgcn_exp2f(mw - (w < 6 ? msel : mwin));
            if (w < 6) { lsel += lw * f; os0 += PO[0] * f; os1 += PO[1] * f; } else { lwin += lw * f; ow0 += PO[0] * f; ow1 += PO[1] * f; } }
        const LAS float* PC = (LAS float*)(L + S_PC) + cq * 64 + cd;
        const size_t mr = (size_t)(MP + b * TS + ct);
        const float g0 = P.ngs[mr * 48 + ch], g1 = P.ngs[mr * 48 + 16 + ch], g2 = P.ngs[mr * 48 + 32 + ch];
        const float is = g1 / lsel, iw = g2 / lwin;
        const float r0 = g0 * PC[0] + os0 * is + ow0 * iw, r1 = g0 * PC[1] + os1 * is + ow1 * iw;
        *(unsigned*)(P.xcat + mr * D + 1024 + ch * 64 + cd) = pk2(r0, r1);
    }
}
__device__ __forceinline__ void attn_sample_stage(const Ptrs& P, LAS unsigned char* L, int bid, int nblk, int tid) {
    for (int u = bid; u < BS * 4; u += nblk) attn_sample_unit(P, L, u >> 2, u & 3, tid);
}

__device__ __forceinline__ float fsig(float x) { return __builtin_amdgcn_rcpf(1.0f + __builtin_amdgcn_exp2f(-x * 1.4426950408889634f)); }
__device__ __forceinline__ float bflo(unsigned u) { return __builtin_bit_cast(float, u << 16); }
__device__ __forceinline__ float bfhi(unsigned u) { return __builtin_bit_cast(float, u & 0xffff0000u); }
struct EpiIn {
    static constexpr bool PERM = true, AFTER_DRAIN = false, HAS_MID = false;
    float* out; float* poolin; bf16_t* qb; bf16_t* kvb; bf16_t* gateb;
    __device__ __forceinline__ void operator()(const pg8::f32x4 (&acc)[2][2][4][2], const pg8::Unit& u, int wr, int wc, int fr, int fq) const {
        const int pn = u.pn, pm = u.pm;
#pragma unroll
        for (int ai = 0; ai < 2; ++ai)
#pragma unroll
            for (int m = 0; m < 4; ++m) {
                const int row = pm * 256 + ai * 128 + wr * 64 + m * 16 + fr;
#pragma unroll
                for (int bj = 0; bj < 2; ++bj) {
                    const int cc = bj * 128 + wc * 32 + 8 * fq; const pg8::f32x4 v0 = acc[ai][bj][m][0], v1 = acc[ai][bj][m][1];
                    if (pn < 4) { float* p = poolin + (size_t)row * PW + pn * 256 + cc; *(pg8::f32x4*)p = v0; *(pg8::f32x4*)(p + 4) = v1; }
                    else if (pn < 8) { v4u w; w.x = pk2(v0[0] * QSCALE, v0[1] * QSCALE); w.y = pk2(v0[2] * QSCALE, v0[3] * QSCALE); w.z = pk2(v1[0] * QSCALE, v1[1] * QSCALE); w.w = pk2(v1[2] * QSCALE, v1[3] * QSCALE);
                        *(v4u*)(qb + (size_t)row * 1024 + (pn - 4) * 256 + cc) = w; }
                    else if (pn < 14) { const int slot = pn - 8; float* dst = nullptr;
                        if (slot < 4) dst = (pm < 32) ? out + O_KVP + (size_t)row * 1024 + slot * 256 + cc : out + O_KVS + (size_t)(row - MP) * 1024 + slot * 256 + cc;
                        else if (pm >= 32) { const int r = row - MP; dst = out + O_WINS + ((size_t)((r >> 2) * 512 + 508 + (r & 3)) * 2 + (slot - 4)) * 256 + cc; }
                        else if ((pm & 7) >= 6) dst = out + O_WINP + ((size_t)((row >> 11) * 512 + (row & 2047) - 1536) * 2 + (slot - 4)) * 256 + cc;
                        if (dst) { *(pg8::f32x4*)dst = v0; *(pg8::f32x4*)(dst + 4) = v1; }
                        if (slot >= 2) { v4u w; w.x = pk2(v0[0], v0[1]); w.y = pk2(v0[2], v0[3]); w.z = pk2(v1[0], v1[1]); w.w = pk2(v1[2], v1[3]); *(v4u*)(kvb + ((size_t)(slot - 2) * M + row) * 256 + cc) = w; } }
                    else { v4u w; w.x = pk2(fsig(v0[0]), fsig(v0[1])); w.y = pk2(fsig(v0[2]), fsig(v0[3])); w.z = pk2(fsig(v1[0]), fsig(v1[1])); w.w = pk2(fsig(v1[2]), fsig(v1[3]));
                        *(v4u*)(gateb + (size_t)row * 4096 + (pn - 14) * 256 + cc) = w; }
                }
            }
    }
};
struct EpiB16 {
    static constexpr bool PERM = true, AFTER_DRAIN = false, HAS_MID = false;
    bf16_t* C; int ldc;
    __device__ __forceinline__ void operator()(const pg8::f32x4 (&acc)[2][2][4][2], const pg8::Unit& u, int wr, int wc, int fr, int fq) const {
#pragma unroll
        for (int ai = 0; ai < 2; ++ai)
#pragma unroll
            for (int m = 0; m < 4; ++m) { const int row = u.pm * 256 + ai * 128 + wr * 64 + m * 16 + fr;
#pragma unroll
                for (int bj = 0; bj < 2; ++bj) { const int col = u.pn * 256 + bj * 128 + wc * 32 + 8 * fq; const pg8::f32x4 v0 = acc[ai][bj][m][0], v1 = acc[ai][bj][m][1];
                    v4u w; w.x = pk2(v0[0], v0[1]); w.y = pk2(v0[2], v0[3]); w.z = pk2(v1[0], v1[1]); w.w = pk2(v1[2], v1[3]); *(v4u*)(C + (size_t)row * ldc + col) = w; } }
    }
};
struct EpiMerge {
    static constexpr bool PERM = true, AFTER_DRAIN = false, HAS_MID = true;
    const bf16_t* gateb; bf16_t* mergedb;
    __device__ __forceinline__ void mid(pg8::f32x4 (&acc)[2][2][4][2], const pg8::Unit& u, int wr, int wc, int fr, int fq) const {
        const bf16_t* gp = gateb + (size_t)(u.pm * 256) * 4096 + u.pn * 256; asm volatile("" : "+s"(gp));
        unsigned lo = (unsigned)((wr * 64 + fr) * 4096 + wc * 32 + 8 * fq); asm volatile("" : "+v"(lo));
#pragma unroll
        for (int ai = 0; ai < 2; ++ai)
#pragma unroll
            for (int m = 0; m < 4; ++m) {
#pragma unroll
                for (int bj = 0; bj < 2; ++bj) { const unsigned off = lo + (unsigned)((ai * 128 + m * 16) * 4096 + bj * 128);
                    const v4u ga = *(const v4u*)(gp + off), gb = *(const v4u*)(gp + off + 2048);
                    const unsigned gaw[4] = {ga.x, ga.y, ga.z, ga.w}, gbw[4] = {gb.x, gb.y, gb.z, gb.w};
#pragma unroll
                    for (int k = 0; k < 4; ++k) { const float r0 = bflo(gaw[k]) * __builtin_amdgcn_rcpf(fmaxf(bflo(gbw[k]), 1e-30f)), r1 = bfhi(gaw[k]) * __builtin_amdgcn_rcpf(fmaxf(bfhi(gbw[k]), 1e-30f));
                        acc[ai][bj][m][k >> 1][(k & 1) * 2] *= r0; acc[ai][bj][m][k >> 1][(k & 1) * 2 + 1] *= r1; } }
                asm volatile("" : "+v"(acc[ai][0][m][0]), "+v"(acc[ai][0][m][1]), "+v"(acc[ai][1][m][0]), "+v"(acc[ai][1][m][1]) :: "memory"); }
    }
    __device__ __forceinline__ void operator()(const pg8::f32x4 (&acc)[2][2][4][2], const pg8::Unit& u, int wr, int wc, int fr, int fq) const {
#pragma unroll
        for (int ai = 0; ai < 2; ++ai)
#pragma unroll
            for (int m = 0; m < 4; ++m) { const int row = u.pm * 256 + ai * 128 + wr * 64 + m * 16 + fr;
#pragma unroll
                for (int bj = 0; bj < 2; ++bj) { const int col = u.pn * 256 + bj * 128 + wc * 32 + 8 * fq;
                    const v4u gb = *(const v4u*)(gateb + (size_t)row * 4096 + 2048 + col); const unsigned gbw[4] = {gb.x, gb.y, gb.z, gb.w}; unsigned w[4];
#pragma unroll
                    for (int k = 0; k < 4; ++k) w[k] = pk2(acc[ai][bj][m][k >> 1][(k & 1) * 2] * fmaxf(bflo(gbw[k]), 1e-30f), acc[ai][bj][m][k >> 1][(k & 1) * 2 + 1] * fmaxf(bfhi(gbw[k]), 1e-30f));
                    v4u o; o.x = w[0]; o.y = w[1]; o.z = w[2]; o.w = w[3]; *(v4u*)(mergedb + (size_t)row * D + col) = o; }
                asm volatile("" ::: "memory"); }
    }
};
#define DPP_F(oldv, src, ctrl) __builtin_bit_cast(float, __builtin_amdgcn_update_dpp(__builtin_bit_cast(int, (float)(oldv)), __builtin_bit_cast(int, (float)(src)), (ctrl), 0xf, 0xf, false))
struct EpiUpAct {
    static constexpr bool PERM = true, AFTER_DRAIN = false, HAS_MID = false;
    bf16_t* actb; float* out; float* ws; const float* conv_w; const float* conv_b;
    __device__ __forceinline__ void operator()(const pg8::f32x4 (&acc)[2][2][4][2], const pg8::Unit& u, int wr, int wc, int fr, int fq) const {
        const int pn = u.pn, pm = u.pm; const bool smp = pm >= 32;
        const int f = pn * 128 + wc * 32 + 8 * fq;
        float cw0[8], cw1[8], cw2[8], cb[8];
        { const F8 a = ld8f(conv_w + f), b = ld8f(conv_w + FF + f), c = ld8f(conv_w + 2 * FF + f), d = ld8f(conv_b + f);
#pragma unroll
          for (int e = 0; e < 8; ++e) { cw0[e] = a.v[e]; cw1[e] = b.v[e]; cw2[e] = c.v[e]; cb[e] = d.v[e]; } }
#pragma unroll
        for (int ai = 0; ai < 2; ++ai)
#pragma unroll
            for (int m = 0; m < 4; ++m) {
                const int row = pm * 256 + ai * 128 + wr * 64 + m * 16 + fr;
                float o[8], gq[8], vq[8];
#pragma unroll
                for (int e = 0; e < 8; ++e) {
                    const float g = acc[ai][1][m][e >> 2][e & 3], gp = (m > 0) ? acc[ai][1][m > 0 ? m - 1 : 0][e >> 2][e & 3] : g, v = acc[ai][0][m][e >> 2][e & 3];
                    const float p1 = DPP_F(DPP_F(0.f, gp, 0x121), g, 0x111);
                    const float p2 = DPP_F(DPP_F(0.f, gp, 0x122), g, 0x112);
                    o[e] = gelu_tanh(cb[e] + cw0[e] * p2 + cw1[e] * p1 + cw2[e] * g) * v; gq[e] = g; vq[e] = v; }
                { v4u w; w.x = pk2(o[0], o[1]); w.y = pk2(o[2], o[3]); w.z = pk2(o[4], o[5]); w.w = pk2(o[6], o[7]); *(v4u*)(actb + (size_t)row * FF + f) = w; }
                if (smp) { const int r = row - MP, t = r & 3;
                    if (t < 2) { const size_t fid = 256 + (size_t)(r >> 2) * 2 + t; F8 a, b;
#pragma unroll
                        for (int e = 0; e < 8; ++e) { a.v[e] = vq[e]; b.v[e] = gq[e]; }
                        st8f(ws + W_FIXV + fid * FF + f, a); st8f(ws + W_FIXG + fid * FF + f, b); }
                    else { F8 b;
#pragma unroll
                        for (int e = 0; e < 8; ++e) b.v[e] = gq[e];
                        st8f(out + O_CONVS + ((size_t)(r >> 2) * 2 + (t - 2)) * FF + f, b); } }
                else {
                    if (m == 0 && fr < 2) { const size_t fid = (size_t)(row >> 6) * 2 + fr; F8 a, b;
#pragma unroll
                        for (int e = 0; e < 8; ++e) { a.v[e] = vq[e]; b.v[e] = gq[e]; }
                        st8f(ws + W_FIXV + fid * FF + f, a); st8f(ws + W_FIXG + fid * FF + f, b); }
                    if (m == 3 && fr >= 14) { F8 b;
#pragma unroll
                        for (int e = 0; e < 8; ++e) b.v[e] = gq[e];
                        st8f(ws + W_TAILG + ((size_t)(row >> 6) * 2 + (fr - 14)) * FF + f, b);
                        if ((row & 2047) >= 2046) st8f(out + O_CONVP + ((size_t)(row >> 11) * 2 + ((row & 2047) - 2046)) * FF + f, b); } }
            }
    }
};
__device__ __forceinline__ void act_fix_stage(const Ptrs& P, size_t gtid, size_t nthr) {
    const float* FV = P.ws + W_FIXV; const float* FG = P.ws + W_FIXG; const float* TG = P.ws + W_TAILG;
    for (size_t i = gtid; i < (size_t)512 * (FF / 8); i += nthr) { const int fid = (int)(i / (FF / 8)), f = (int)(i % (FF / 8)) * 8;
        F8 g1, g2; int row;
#pragma unroll
        for (int e = 0; e < 8; ++e) { g1.v[e] = 0.f; g2.v[e] = 0.f; }
        if (fid < 256) { const int blk = fid >> 1, ii = fid & 1; row = blk * 64 + ii; const int t = row & 2047;
            if (ii == 0) { if (t != 0) { g1 = ld8f(TG + ((size_t)(blk - 1) * 2 + 1) * FF + f); g2 = ld8f(TG + ((size_t)(blk - 1) * 2 + 0) * FF + f); } }
            else { g1 = ld8f(FG + (size_t)(fid - 1) * FF + f); if (t != 1) g2 = ld8f(TG + ((size_t)(blk - 1) * 2 + 1) * FF + f); } }
        else { const int sidx = fid - 256, b = sidx >> 1, t = sidx & 1; row = MP + b * TS + t;
            if (t == 0) { g1 = ld8f(P.sconv + ((size_t)b * 2 + 1) * FF + f); g2 = ld8f(P.sconv + ((size_t)b * 2 + 0) * FF + f); }
            else { g1 = ld8f(FG + (size_t)(fid - 1) * FF + f); g2 = ld8f(P.sconv + ((size_t)b * 2 + 1) * FF + f); } }
        const F8 g0 = ld8f(FG + (size_t)fid * FF + f), vv = ld8f(FV + (size_t)fid * FF + f), c0 = ld8f(P.conv_w + f), c1 = ld8f(P.conv_w + FF + f), c2 = ld8f(P.conv_w + 2 * FF + f), cb = ld8f(P.conv_b + f);
        F8 o;
#pragma unroll
        for (int e = 0; e < 8; ++e) o.v[e] = gelu_tanh(cb.v[e] + c0.v[e] * g2.v[e] + c1.v[e] * g1.v[e] + c2.v[e] * g0.v[e]) * vv.v[e];
        st8h(P.actb + (size_t)row * FF + f, o); }
}
__device__ __forceinline__ void merge_sample_stage(const Ptrs& P, size_t gtid, size_t nthr) {
    const bf16_t* SL = (const bf16_t*)(P.ws + W_SLABM);
    for (size_t i = gtid; i < (size_t)MS * D / 8; i += nthr) { const int r = (int)(i >> 8), c = (int)(i & 255) * 8;
        F8 a, b;
#pragma unroll
        for (int e = 0; e < 8; ++e) { a.v[e] = 0.f; b.v[e] = 0.f; }
#pragma unroll
        for (int k = 0; k < 4; ++k) { const F8 x = ld8h(SL + (size_t)k * MS * D + (size_t)r * D + c), y = ld8h(SL + (size_t)(k + 4) * MS * D + (size_t)r * D + c);
#pragma unroll
            for (int e = 0; e < 8; ++e) { a.v[e] += x.v[e]; b.v[e] += y.v[e]; } }
        const F8 ga = ld8h(P.gateb + (size_t)(MP + r) * 4096 + c), gb = ld8h(P.gateb + (size_t)(MP + r) * 4096 + 2048 + c);
        F8 o;
#pragma unroll
        for (int e = 0; e < 8; ++e) o.v[e] = ga.v[e] * a.v[e] + gb.v[e] * b.v[e];
        st8h(P.mergedb + (size_t)(MP + r) * D + c, o); }
}
__device__ __forceinline__ float4 pool_prev(const Ptrs& P, const float* PI, int m, int t, int j, bool isP, int b, int c) {
    const int tt = t - j;
    if (tt >= 0) return *(const float4*)(PI + (size_t)(m - j) * PW + c);
    if (!isP) return *(const float4*)(P.spool + ((size_t)b * 15 + 15 + tt) * 1024 + c);
    return make_float4(0.f, 0.f, 0.f, 0.f);
}
__device__ __forceinline__ void pool_stage(const Ptrs& P, size_t gtid, size_t nthr) {
    const float* PI = P.ws + W_POOLIN;
    const int nseg = (int)(nthr >> 8), seg = (int)(gtid >> 8), c = (int)(gtid & 255) * 4, w = 2 << (c >> 8);
    if (nseg > 0 && seg < nseg) {
        const int rps = (M + nseg - 1) / nseg, mb = seg * rps, me = (mb + rps < M) ? mb + rps : M;
        float4 S = make_float4(0.f, 0.f, 0.f, 0.f);
        int m = mb;
        while (m < me) {
            const bool isP = m < MP; const int b = isP ? m / TP : (m - MP) / TS, t = isP ? m % TP : (m - MP) % TS;
            if (m != mb && isP && t >= w && t + 7 < TP && m + 7 < me) {
                float4 x[8], v[8];
#pragma unroll
                for (int i = 0; i < 8; ++i) { x[i] = *(const float4*)(PI + (size_t)(m + i) * PW + c); v[i] = *(const float4*)(PI + (size_t)(m + i - w) * PW + c); }
                const float ic = 1.0f / (float)w;
#pragma unroll
                for (int i = 0; i < 8; ++i) { S.x += x[i].x - v[i].x; S.y += x[i].y - v[i].y; S.z += x[i].z - v[i].z; S.w += x[i].w - v[i].w;
                    uint2 o; o.x = pk2(S.x * ic - x[i].x, S.y * ic - x[i].y); o.y = pk2(S.z * ic - x[i].z, S.w * ic - x[i].w); *(uint2*)(P.xcat + (size_t)(m + i) * D + c) = o; }
                m += 8;
            } else {
                const float4 x = *(const float4*)(PI + (size_t)m * PW + c);
                if (m == mb || t == 0) { S = x;
#pragma unroll
                    for (int jj = 1; jj < 16; ++jj) { const int tt = t - jj; const bool inw = jj < w; const bool fromPI = inw && tt >= 0, fromS = inw && tt < 0 && !isP;
                        const float* p = fromPI ? PI + (size_t)(m - jj) * PW + c : (fromS ? P.spool + ((size_t)b * 15 + 15 + tt) * 1024 + c : PI + (size_t)m * PW + c);
                        const float4 vv = *(const float4*)p; const float sc = (fromPI || fromS) ? 1.0f : 0.0f;
                        S.x += vv.x * sc; S.y += vv.y * sc; S.z += vv.z * sc; S.w += vv.w * sc; } }
                else { const float4 v = pool_prev(P, PI, m, t, w, isP, b, c); S.x += x.x - v.x; S.y += x.y - v.y; S.z += x.z - v.z; S.w += x.w - v.w; }
                const int pos = isP ? t : PAST + t; const float ic = 1.0f / (float)((w < pos + 1) ? w : pos + 1);
                uint2 o; o.x = pk2(S.x * ic - x.x, S.y * ic - x.y); o.y = pk2(S.z * ic - x.z, S.w * ic - x.w); *(uint2*)(P.xcat + (size_t)m * D + c) = o;
                ++m;
            }
        }
    }
    for (size_t i = gtid; i < (size_t)BP * 15 * 256; i += nthr) { const int c = (int)(i & 255) * 4; const int r = (int)(i >> 8); const int b = r / 15, j = r % 15;
        *(float4*)(P.out + O_POOLP + (size_t)r * 1024 + c) = *(const float4*)(PI + (size_t)(b * TP + (TP - 15) + j) * PW + c); }
    for (size_t i = gtid; i < (size_t)BS * 4 * 256; i += nthr) { const int c = (int)(i & 255) * 4; const int r = (int)(i >> 8); const int b = r >> 2, j = r & 3;
        *(float4*)(P.out + O_POOLS + ((size_t)b * 15 + 11 + j) * 1024 + c) = *(const float4*)(PI + (size_t)(MP + b * TS + j) * PW + c); }
}
__device__ __forceinline__ void prologue_state_copies(const Ptrs& P, size_t gtid, size_t nthr) {
    for (size_t i = gtid; i < (size_t)BS * 11 * 256; i += nthr) { const int c = (int)(i & 255) * 4; const int r = (int)(i >> 8); const int b = r / 11, j = r % 11;
        *(float4*)(P.out + O_POOLS + ((size_t)b * 15 + j) * 1024 + c) = *(const float4*)(P.spool + ((size_t)b * 15 + j + 4) * 1024 + c); }
}
#define XB_TMO      128
#define XB_XCNT(j)  (256  + 64 * (j))
#define XB_XSUB(j)  (1280 + 64 * (j))
#define XB_XGEN(j)  (2304 + 64 * (j))
#define XB_TOP      3328
#define XB_TOPGEN   3392
#define XCD_BAR_WORDS 3456
#define XB_SPIN_CAP (1u << 22)

__device__ __forceinline__ unsigned xb_ld(unsigned* p)              { return __hip_atomic_load(p, __ATOMIC_RELAXED, __HIP_MEMORY_SCOPE_AGENT); }
__device__ __forceinline__ unsigned xb_add(unsigned* p, unsigned v) { return __hip_atomic_fetch_add(p, v, __ATOMIC_RELAXED, __HIP_MEMORY_SCOPE_AGENT); }
__device__ __forceinline__ unsigned xb_xcc_id() { return (unsigned)__builtin_amdgcn_s_getreg((3 << 11) | 20) & 0xFu; }
#define XB_SPIN(cond, bar) do { unsigned _sp = 0; while (cond) { __builtin_amdgcn_s_sleep(1); \
    if ((++_sp & 255u) == 0u) { if (xb_ld(&(bar)[XB_TMO])) break; if (_sp > XB_SPIN_CAP) { atomicAdd(&(bar)[XB_TMO], 1u); break; } } } } while (0)

struct XcdBarrier {
    unsigned* bar; unsigned x;
    volatile LAS unsigned* st;
    int wv;
};

__device__ __forceinline__ XcdBarrier xcd_barrier_post(unsigned* bar, volatile LAS unsigned* st) {
    XcdBarrier b; b.bar = bar; b.x = xb_xcc_id(); b.st = st;
    if (threadIdx.x == 0) (void)xb_add(&bar[XB_XCNT(b.x)], 1u);
    return b;
}
__device__ __forceinline__ void xcd_barrier_complete(unsigned* bar, unsigned x, unsigned& nloc, unsigned& nx) {
    const unsigned G = gridDim.x * gridDim.y * gridDim.z;
    unsigned sum, cnt, mine, sp = 0u;
    for (;;) {
        sum = 0u; cnt = 0u; mine = 0u;
#pragma unroll
        for (unsigned j = 0; j < 16; ++j) { const unsigned c = xb_ld(&bar[XB_XCNT(j)]); sum += c; cnt += (c > 0u) ? 1u : 0u; mine = (j == x) ? c : mine; }
        if (sum == G) break;
        __builtin_amdgcn_s_sleep(1);
        if ((++sp & 255u) == 0u) { if (xb_ld(&bar[XB_TMO])) break; if (sp > XB_SPIN_CAP) { atomicAdd(&bar[XB_TMO], 1u); break; } }
    }
    nloc = mine > 0u ? mine : 1u; nx = cnt > 0u ? cnt : 1u;
}

__device__ __forceinline__ void xcd_barrier(const XcdBarrier& b) {
    asm volatile("s_waitcnt vmcnt(0)" ::: "memory");
    __syncthreads();
    int xb_lane; asm volatile("v_mbcnt_lo_u32_b32 %0, -1, 0\n\tv_mbcnt_hi_u32_b32 %0, -1, %0" : "=v"(xb_lane));
    if (b.wv == 0 && xb_lane == 0) {
        unsigned* bar = b.bar;
        __builtin_amdgcn_s_waitcnt(0);
        unsigned nloc = b.st[0], nx = b.st[1];
        if (nloc == 0u) { xcd_barrier_complete(bar, b.x, nloc, nx); b.st[0] = nloc; b.st[1] = nx; }
        const unsigned old = xb_add(&bar[XB_XSUB(b.x)], 1u);
        const unsigned gen = old / nloc;
        if (old + 1u == (gen + 1u) * nloc) {
            __builtin_amdgcn_fence(__ATOMIC_RELEASE, "agent");
            asm volatile("s_waitcnt vmcnt(0)" ::: "memory");
            const unsigned og = xb_add(&bar[XB_TOP], 1u);
            const unsigned tg = og / nx;
            if (og + 1u == (tg + 1u) * nx) xb_add(&bar[XB_TOPGEN], 1u);
            else XB_SPIN(xb_ld(&bar[XB_TOPGEN]) == tg, bar);
            __builtin_amdgcn_fence(__ATOMIC_ACQUIRE, "agent");
            xb_add(&bar[XB_XGEN(b.x)], 1u);
            asm volatile("s_waitcnt vmcnt(0)" ::: "memory");
        } else {
            XB_SPIN(xb_ld(&bar[XB_XGEN(b.x)]) == gen, bar);
            __builtin_amdgcn_fence(__ATOMIC_ACQUIRE, "agent");
            asm volatile("s_waitcnt vmcnt(0)" ::: "memory");
        }
    }
    __syncthreads();
}


constexpr int LDS_BYTES = 147456;
constexpr int MISC_OFF = 131072 + 320;

struct Args { Ptrs P; unsigned* bar; };
static_assert(sizeof(Ptrs) % 8 == 0, "Ptrs is copied as 64-bit words");

__global__ void __launch_bounds__(512, 2) mega(Args a) {
    extern __shared__ __attribute__((aligned(16))) unsigned char lds[];
    volatile LAS unsigned* MISC = (volatile LAS unsigned*)((LAS unsigned char*)lds + MISC_OFF);
    if (threadIdx.x < 32) MISC[threadIdx.x] = 0u;
    __syncthreads();
    const int wave_s = __builtin_amdgcn_readfirstlane(threadIdx.x >> 6);
    XcdBarrier bar = xcd_barrier_post(a.bar, MISC + 8); bar.wv = wave_s;
    const int bid = blockIdx.x, nblk = gridDim.x;
    float* fl = (float*)lds;
    PG8_LAS unsigned char* glds = (PG8_LAS unsigned char*)lds;
#if defined(__HIP_DEVICE_COMPILE__)
#define PFRESH() const __attribute__((address_space(4))) unsigned long long* kp_ = (const __attribute__((address_space(4))) unsigned long long*)__builtin_amdgcn_kernarg_segment_ptr(); asm volatile("" : "+s"(kp_)); \
                 union { Ptrs P; unsigned long long w[sizeof(Ptrs) / 8]; } pu_; _Pragma("unroll") for (int i_ = 0; i_ < (int)(sizeof(Ptrs) / 8); ++i_) pu_.w[i_] = kp_[i_]; \
                 const Ptrs& P = pu_.P; float* ws = P.ws; (void)ws;
#else
#define PFRESH() const Ptrs& P = a.P; float* ws = P.ws; (void)ws;
#endif
#define FRESH() int lane; asm volatile("v_mbcnt_lo_u32_b32 %0, -1, 0\n\tv_mbcnt_hi_u32_b32 %0, -1, %0" : "=v"(lane)); const int wave = wave_s, tid = wave_s * 64 + lane, gwave = bid * 8 + wave, nwaves = nblk * 8; \
                const size_t gtid = (size_t)bid * 512 + tid, nthr = (size_t)nblk * 512; (void)tid; (void)wave; (void)gwave; (void)nwaves; (void)gtid; (void)nthr; PFRESH();

    const bool defer = (nblk == 256);
    { FRESH(); prologue_transposes(P, lds, 0, defer ? TR_P0 : TR_ALL, gwave, nwaves, wave, lane); }
    __syncthreads();
    { FRESH(); prologue_wprime(P, fl, bid, nblk, tid); }
    { FRESH(); prologue_ng(P, gtid, nthr); prologue_cmp(P, gtid, nthr, gwave, nwaves, lane); prologue_state_copies(P, gtid, nthr); rms_stage<0>(P, gwave, nwaves, lane); }
    xcd_barrier(bar);
#pragma nounroll
    for (int step = 0; step < 2; ++step) {
        if (((step ^ bid) & 1) == 0) {
            PFRESH(); pg8::Gemm g{P.ub, P.wt_in, M, NIN, D, D, D}; pg8::StaticOrder S; S.init(M, NIN, nblk, bid); EpiIn E{P.out, ws + W_POOLIN, P.qb, P.kvb, P.gateb};
            pg8::gemm_phase<EpiIn, pg8::StaticOrder, true, true>(glds, g, S, E, wave_s);
        } else {
            { FRESH(); ng_stage(P, bid, nblk, wave, lane); }
            { FRESH(); compress_sample_lds(P, glds, bid, nblk, wave, lane, tid); }
        }
        __syncthreads();
    }
    xcd_barrier(bar);
    if (nblk > 64 && bid >= 32) { FRESH(); pool_stage(P, gtid - (size_t)32 * 512, nthr - (size_t)32 * 512); }
    else if (nblk > 64) { FRESH(); compress_prompt_split(P, glds, bid, wave, lane); }
    else { FRESH(); pool_stage(P, gtid, nthr); compress_mfma<1, true>(P, gwave, nwaves, lane); }
    xcd_barrier(bar);
    if ((bid >> 3) & 1) { { FRESH(); attn_sample_stage(P, glds, bid, nblk, tid); } { FRESH(); attn_prompt_stage(P, glds, bid, nblk, tid); } }
    else { { FRESH(); attn_prompt_stage(P, glds, bid, nblk, tid); } { FRESH(); attn_sample_stage(P, glds, bid, nblk, tid); } }
    xcd_barrier(bar);
    { PFRESH(); pg8::Gemm g{P.xcat, P.wt_pn, MP, D, D, D, D}; pg8::StaticOrder S; S.init(MP, D, nblk, bid); EpiMerge E{P.gateb, P.mergedb};
      pg8::gemm_phase<EpiMerge, pg8::StaticOrder, true, true>(glds, g, S, E, wave_s); }
    { PFRESH(); pg8::Gemm g{P.xcat, P.wt_pn, M, D, 256, D, D}; pg8::SplitOrder S{nblk, bid, 8, 256, MP / 256, D / 256}; pg8::EpiSlab E{(bf16_t*)(ws + W_SLABM), D, 256, MP / 256, (size_t)MS * D};
      pg8::gemm_phase<pg8::EpiSlab, pg8::SplitOrder, true, true>(glds, g, S, E, wave_s); }
    if (defer && bid >= 128) { FRESH(); prologue_transposes(P, lds, TR_P0, TR_SLOTA, (bid - 128) * 8 + wave, 1024, wave, lane); }
    xcd_barrier(bar);
    { FRESH(); merge_sample_stage(P, gtid, nthr); }
    xcd_barrier(bar);
    { PFRESH(); pg8::Gemm g{P.mergedb, P.wt_out, MP, D, D, D, D}; pg8::StaticOrder S; S.init(MP, D, nblk, bid); EpiB16 E{P.tb, D};
      pg8::gemm_phase<EpiB16, pg8::StaticOrder, true, true>(glds, g, S, E, wave_s); }
    { PFRESH(); pg8::Gemm g{P.mergedb, P.wt_out, M, D, 256, D, D}; pg8::SplitOrder S{nblk, bid, 8, 256, MP / 256, D / 256}; pg8::EpiSlab E{(bf16_t*)(ws + W_SLAB), D, 256, MP / 256, (size_t)MS * D};
      pg8::gemm_phase<pg8::EpiSlab, pg8::SplitOrder, true, true>(glds, g, S, E, wave_s); }
    if (defer && bid >= 128) { FRESH(); prologue_transposes(P, lds, TR_SLOTA, TR_UP, (bid - 128) * 8 + wave, 1024, wave, lane); }
    xcd_barrier(bar);
    { FRESH(); rms_stage<1>(P, gwave, nwaves, lane); }
    xcd_barrier(bar);
    { PFRESH(); pg8::Gemm g{P.u2b, P.wt_up, M, 2 * FF, D, D, D}; pg8::StaticOrder S; S.init(M, 2 * FF, nblk, bid); EpiUpAct E{P.actb, P.out, ws, P.conv_w, P.conv_b};
      pg8::gemm_phase<EpiUpAct, pg8::StaticOrder, false, true>(glds, g, S, E, wave_s); }
    if (defer && bid >= 216) { FRESH(); prologue_transposes(P, lds, TR_UP, TR_ALL, (bid - 216) * 8 + wave, 320, wave, lane); }
    xcd_barrier(bar);
    { FRESH(); act_fix_stage(P, gtid, nthr); }
    xcd_barrier(bar);
    { PFRESH(); pg8::Gemm g{P.actb, P.wt_down, MP, D, FF, FF, FF}; pg8::StaticOrder S; S.init(MP, D, nblk, bid); EpiB16 E{P.tb, D};
      pg8::gemm_phase<EpiB16, pg8::StaticOrder, true, true>(glds, g, S, E, wave_s); }
    { PFRESH(); pg8::Gemm g{P.actb, P.wt_down, M, D, 512, FF, FF}; pg8::SplitOrder S{nblk, bid, 11, 512, MP / 256, D / 256}; pg8::EpiSlab E{(bf16_t*)(ws + W_SLAB), D, 512, MP / 256, (size_t)MS * D};
      pg8::gemm_phase<pg8::EpiSlab, pg8::SplitOrder, true, true>(glds, g, S, E, wave_s); }
    xcd_barrier(bar);
    { FRESH(); rms_stage<2>(P, gwave, nwaves, lane); }
#undef FRESH
#undef PFRESH
}
}

extern "C" void kernel_launch(void* const* d_in, const int* in_sizes, int n_in, void* d_out, int out_size, void* d_ws, size_t ws_size, hipStream_t stream) {
    if (n_in != 28 || (size_t)out_size != O_END || ws_size < WS_TOTAL) return;
    static int grid = 0;
    if (grid == 0) {
        int dev = 0, cus = 0, per_cu = 0;
        if (hipGetDevice(&dev) != hipSuccess || hipDeviceGetAttribute(&cus, hipDeviceAttributeMultiprocessorCount, dev) != hipSuccess) { grid = -1; return; }
        if (hipFuncSetAttribute((const void*)mega, hipFuncAttributeMaxDynamicSharedMemorySize, LDS_BYTES) != hipSuccess) { grid = -1; return; }
        if (hipOccupancyMaxActiveBlocksPerMultiprocessor(&per_cu, (const void*)mega, 512, LDS_BYTES) != hipSuccess || per_cu < 1) { (void)hipGetLastError(); per_cu = 1; }
        grid = cus;
    }
    if (grid < 0) return;
    (void)hipMemsetAsync(d_ws, 0, WS_CTL_BYTES, stream);
    Args a{};
    Ptrs& P = a.P;
    P.xp = (const float*)d_in[0]; P.xs = (const float*)d_in[1]; P.cache = (const float*)d_in[2]; P.pt = (const int*)d_in[3]; P.swin = (const float*)d_in[4];
    P.spool = (const float*)d_in[5]; P.sconv = (const float*)d_in[6]; P.g_pre = (const float*)d_in[7]; P.w_in = (const float*)d_in[8];
    P.pe_k = (const float*)d_in[9]; P.w1_k = (const float*)d_in[10]; P.w2_k = (const float*)d_in[11]; P.pe_v = (const float*)d_in[12]; P.w1_v = (const float*)d_in[13]; P.w2_v = (const float*)d_in[14];
    P.rel_bias = (const float*)d_in[15]; P.w_pgrp = (const float*)d_in[16]; P.pool_scale = (const float*)d_in[17]; P.w_pproj = (const float*)d_in[18]; P.w_nproj = (const float*)d_in[19];
    P.w_out = (const float*)d_in[20]; P.g_pmix = (const float*)d_in[21]; P.g_pffn = (const float*)d_in[22]; P.w_up = (const float*)d_in[23]; P.conv_w = (const float*)d_in[24];
    P.conv_b = (const float*)d_in[25]; P.w_down = (const float*)d_in[26]; P.g_postffn = (const float*)d_in[27];
    P.out = (float*)d_out; P.ws = (float*)((char*)d_ws + WS_F32_OFF);
    bf16_t* hb = (bf16_t*)((char*)d_ws + WS_H_OFF);
    P.ub = hb + H_UB; P.xcat = hb + H_XCAT; P.mergedb = hb + H_MERGEDB; P.u2b = hb + H_U2B; P.upb = hb + H_UPB; P.actb = hb + H_ACTB; P.gateb = hb + H_GATEB;
    P.wt_in = hb + H_WTIN; P.wt_ng = hb + H_WTNG; P.wt_pn = hb + H_WTPN; P.wt_out = hb + H_WTOUT; P.wt_up = hb + H_WTUP; P.wt_down = hb + H_WTDOWN;
    P.qb = hb + H_QB; P.kvb = hb + H_KVB; P.kcb = hb + H_KCB; P.vcb = hb + H_VCB; P.w1f = hb + H_W1F; P.w2f = hb + H_W2F; P.tb = hb + H_TB; P.ngs = P.ws + W_NGS; P.c1 = P.ws + W_C1;
    a.bar = (unsigned*)d_ws + 4096;
    hipLaunchKernelGGL(mega, dim3(grid), dim3(512), LDS_BYTES, stream, a);
}
```

```cpp
#include <hip/hip_runtime.h>
#include <stdint.h>
#include <math.h>

namespace pg8 {
#define PG8_LAS __attribute__((address_space(3)))
typedef unsigned short bf16_t;
typedef short bf16x8 __attribute__((ext_vector_type(8)));
typedef float f32x4 __attribute__((ext_vector_type(4)));
typedef unsigned u32x4 __attribute__((ext_vector_type(4)));
constexpr int BM = 256, BK = 64, HALF = 128, HTB = HALF * BK * 2  , STAGE_BYTES = 8 * HTB, NXCD = 8, WGM = 8;

__host__ __device__ __forceinline__ int lds_byte(int r, int c) { const int st = (r >> 4) * 2 + (c >> 5), rr = r & 15, cc = c & 31, ob = rr * 64 + cc * 2; return st * 1024 + (ob ^ (((ob >> 9) & 1) << 5)); }
__host__ __device__ __forceinline__ void stage_rc(int b, int& R, int& C) { const int st = b / 1024, sb = b % 1024, swz = sb ^ (((sb >> 9) & 1) << 5); R = (st >> 1) * 16 + swz / 64; C = (st & 1) * 32 + (swz % 64) / 2; }
__host__ __device__ __forceinline__ int perm32(int rho) { const int n = rho >> 4, i = rho & 15; return 8 * (i >> 2) + 4 * n + (i & 3); }

struct Unit { int pm, pn, koff; };
struct Gemm { const bf16_t* A; const bf16_t* Bt; int M, N, K, lda, ldb; };
struct StaticOrder {
    int nM, nN, nwg, G, c;
    __host__ __device__ void init(int M, int N, int G_, int c_) { nM = M / BM; nN = N / BM; nwg = nM * nN; G = G_; c = c_; }
    __host__ __device__ bool next(int i, Unit& u) const {
        const long L = (long)i * G + c; if (L >= nwg) return false;
        int wgid = (int)L; { const int q = nwg / NXCD, r = nwg % NXCD, xcd = wgid % NXCD, off = wgid / NXCD; wgid = (xcd < r ? xcd * (q + 1) : r * (q + 1) + (xcd - r) * q) + off; }
        const int nig = WGM * nN, gid = wgid / nig, fm = gid * WGM, gsz = (nM - fm) < WGM ? (nM - fm) : WGM;
        u.pm = fm + ((wgid % nig) % gsz); u.pn = (wgid % nig) / gsz; u.koff = 0; return true;
    }
    __device__ __forceinline__ void a_ready(const Unit&) const {}
    __device__ __forceinline__ void done(const Unit&) const {}
};
__device__ __forceinline__ unsigned cvt_pk_bf16(float lo, float hi) { unsigned r; asm volatile("v_cvt_pk_bf16_f32 %0, %1, %2" : "=v"(r) : "v"(lo), "v"(hi)); return r; }
struct EpiF32X {
    static constexpr bool PERM = false, AFTER_DRAIN = false, HAS_MID = false;
    float* C; int ldc; int split_pn; int split_add;
    __device__ __forceinline__ void operator()(const f32x4 (&acc)[2][2][4][2], const Unit& u, int wr, int wc, int fr, int fq) const {
        const int row0 = u.pm * BM + wr * 64 + fr, col0 = u.pn * BM + (u.pn >= split_pn ? split_add : 0) + wc * 32 + 4 * fq;
#pragma unroll
        for (int ai = 0; ai < 2; ++ai)
#pragma unroll
            for (int m = 0; m < 4; ++m) { float* rowp = C + (size_t)(row0 + ai * HALF + m * 16) * ldc + col0;
#pragma unroll
                for (int bj = 0; bj < 2; ++bj)
#pragma unroll
                    for (int n = 0; n < 2; ++n) *(f32x4*)(rowp + bj * HALF + n * 16) = acc[ai][bj][m][n]; }
    }
};
struct SplitOrder {
    int G, c, S, Ks, pm0, nN;
    __device__ __forceinline__ bool next(int i, Unit& u) const { const int L = i * G + c; if (L >= 2 * nN * S) return false; const int ks = L % S, t = L / S; u.pm = pm0 + (t & 1); u.pn = t >> 1; u.koff = ks * Ks; return true; }
    __device__ __forceinline__ void a_ready(const Unit&) const {}
    __device__ __forceinline__ void done(const Unit&) const {}
};
typedef unsigned u32x2 __attribute__((ext_vector_type(2)));
struct EpiSlab {
    static constexpr bool PERM = false, AFTER_DRAIN = false, HAS_MID = false;
    unsigned short* C; int ldc; int Ks; int pm0; size_t slab;
    __device__ __forceinline__ void operator()(const f32x4 (&acc)[2][2][4][2], const Unit& u, int wr, int wc, int fr, int fq) const {
        const int row0 = (u.pm - pm0) * BM + wr * 64 + fr, col0 = u.pn * BM + wc * 32 + 4 * fq; unsigned short* base = C + (size_t)(u.koff / Ks) * slab;
#pragma unroll
        for (int ai = 0; ai < 2; ++ai)
#pragma unroll
            for (int m = 0; m < 4; ++m) { unsigned short* rowp = base + (size_t)(row0 + ai * HALF + m * 16) * ldc + col0;
#pragma unroll
                for (int bj = 0; bj < 2; ++bj)
#pragma unroll
                    for (int n = 0; n < 2; ++n) { u32x2 w; w.x = cvt_pk_bf16(acc[ai][bj][m][n][0], acc[ai][bj][m][n][1]); w.y = cvt_pk_bf16(acc[ai][bj][m][n][2], acc[ai][bj][m][n][3]);
                        *(u32x2*)(rowp + bj * HALF + n * 16) = w; } }
    }
};
template <class Epi, class Sched, bool ALIGN_EPI = false, bool SP2 = false>
__device__ __forceinline__ void gemm_phase(PG8_LAS unsigned char* lds, const Gemm g, const Sched& S, const Epi& E, const int wid) {
    int lane; asm volatile("v_mbcnt_lo_u32_b32 %0, -1, 0\n\tv_mbcnt_hi_u32_b32 %0, -1, %0" : "=v"(lane));
    const int wu = __builtin_amdgcn_readfirstlane(wid);
    const int tid = wu * 64 + lane, wr = wu >> 2, wc = wu & 3, fr = lane & 15, fq = lane >> 4;
    const int K = g.K, nt = K / BK;
    unsigned voffA[2], voffB[2];
#pragma unroll
    for (int i = 0; i < 2; ++i) { int R, C; stage_rc(tid * 16 + i * 8192, R, C); const int Rb = Epi::PERM ? ((R & ~31) + perm32(R & 31)) : R;
        voffA[i] = (unsigned)(R * g.lda + C) * 2u; voffB[i] = (unsigned)(Rb * g.ldb + C) * 2u; }
    const size_t kstep = (size_t)(BK * 2);
    const size_t hstepA = (size_t)HALF * g.lda * 2, hstepB = (size_t)HALF * g.ldb * 2;
    const size_t tstepA = 2 * hstepA, tstepB = 2 * hstepB;
    const unsigned ldsw = (unsigned)wu * 1024u;
    const int aoff = lds_byte(wr * 64 + fr, fq * 8), boff = lds_byte(wc * 32 + fr, fq * 8);
#define PG8_SA(b, h) (((b) * 2 + (h)) * HTB)
#define PG8_SB(b, h) ((4 + (b) * 2 + (h)) * HTB)
#define PG8_STAGE(bufoff, gbase, voff) do { _Pragma("unroll") for (int _i = 0; _i < 2; ++_i) \
        __builtin_amdgcn_global_load_lds((const unsigned*)((const char*)(gbase) + (voff)[_i]), (PG8_LAS unsigned*)(lds + (bufoff) + ldsw + _i * 8192), 16, 0, 0); } while (0)
#define PG8_LDA(dst, b, h) do { _Pragma("unroll") for (int m = 0; m < 4; ++m) _Pragma("unroll") for (int k = 0; k < 2; ++k) dst[m][k] = *(const PG8_LAS bf16x8*)(lds + PG8_SA(b, h) + aoff + m * 2048 + k * 1024); } while (0)
#define PG8_LDB(dst, b, h) do { _Pragma("unroll") for (int n = 0; n < 2; ++n) _Pragma("unroll") for (int k = 0; k < 2; ++k) dst[n][k] = *(const PG8_LAS bf16x8*)(lds + PG8_SB(b, h) + boff + n * 2048 + k * 1024); } while (0)
#define PG8_MMA(ai, bj, At, Bt) do { __builtin_amdgcn_s_setprio(1); _Pragma("unroll") for (int m = 0; m < 4; ++m) _Pragma("unroll") for (int n = 0; n < 2; ++n) _Pragma("unroll") for (int k = 0; k < 2; ++k) \
        acc[ai][bj][m][n] = __builtin_amdgcn_mfma_f32_16x16x32_bf16(Bt[n][k], At[m][k], acc[ai][bj][m][n], 0, 0, 0); __builtin_amdgcn_s_setprio(0); } while (0)
#define PG8_WAIT_V(n) asm volatile("s_waitcnt vmcnt(" #n ")" ::: "memory")
#define PG8_WAIT_L(n) asm volatile("s_waitcnt lgkmcnt(" #n ")" ::: "memory")
#define PG8_BAR __builtin_amdgcn_s_barrier()
#define PG8_SCHED __builtin_amdgcn_sched_barrier(0)
    Unit cur, nxt; int ui = 0;
    if (!S.next(0, cur)) return;
    f32x4 acc[2][2][4][2];
#pragma unroll
    for (int a = 0; a < 2; ++a)
#pragma unroll
        for (int b = 0; b < 2; ++b)
#pragma unroll
            for (int m = 0; m < 4; ++m)
#pragma unroll
                for (int n = 0; n < 2; ++n) acc[a][b][m][n] = (f32x4){0.f, 0.f, 0.f, 0.f};
    bf16x8 At[4][2], B0[2][2], B1[2][2];
    const char* cA = (const char*)g.A + (size_t)cur.pm * tstepA + (size_t)cur.koff * 2; const char* cB = (const char*)g.Bt + (size_t)cur.pn * tstepB + (size_t)cur.koff * 2;
    S.a_ready(cur);
    if constexpr (SP2) {
        PG8_STAGE(PG8_SB(0, 0), cB, voffB); PG8_STAGE(PG8_SB(0, 1), cB + hstepB, voffB); PG8_STAGE(PG8_SA(0, 0), cA, voffA); PG8_STAGE(PG8_SA(0, 1), cA + hstepA, voffA);
        if (wr == 1) PG8_BAR;
        PG8_WAIT_V(2); PG8_BAR;
        PG8_STAGE(PG8_SB(1, 0), cB + kstep, voffB); PG8_STAGE(PG8_SA(1, 0), cA + kstep, voffA); PG8_STAGE(PG8_SB(1, 1), cB + hstepB + kstep, voffB);
        PG8_WAIT_V(6); PG8_BAR;
    } else {
        PG8_STAGE(PG8_SB(0, 0), cB, voffB); PG8_STAGE(PG8_SA(0, 0), cA, voffA); PG8_STAGE(PG8_SB(0, 1), cB + hstepB, voffB); PG8_STAGE(PG8_SA(0, 1), cA + hstepA, voffA);
        if (wr == 1) PG8_BAR;
        PG8_WAIT_V(4); PG8_BAR;
        PG8_STAGE(PG8_SB(1, 0), cB + kstep, voffB); PG8_STAGE(PG8_SA(1, 0), cA + kstep, voffA); PG8_STAGE(PG8_SB(1, 1), cB + hstepB + kstep, voffB);
        PG8_WAIT_V(6); PG8_BAR;
    }
    for (;;) {
        const bool has_next = S.next(ui + 1, nxt);
        const char* nA = has_next ? (const char*)g.A + (size_t)nxt.pm * tstepA + (size_t)nxt.koff * 2 : cA; const char* nB = has_next ? (const char*)g.Bt + (size_t)nxt.pn * tstepB + (size_t)nxt.koff * 2 : cB;
        for (int t = 0; t < nt; t += 2) {
            const bool last = (t == nt - 2);
            const char* a1 = cA + (size_t)(t + 1) * kstep;
            const char* a2 = last ? nA : cA + (size_t)(t + 2) * kstep; const char* b2 = last ? nB : cB + (size_t)(t + 2) * kstep;
            const char* a3 = a2 + kstep; const char* b3 = b2 + kstep;
            if (last && has_next) S.a_ready(nxt);
            if constexpr (Epi::HAS_MID) { if (t == (nt >> 1)) E.mid(acc, cur, wr, wc, fr, fq); }
            if constexpr (SP2) {
            PG8_LDB(B0, 0, 0); PG8_LDB(B1, 0, 1); PG8_SCHED; PG8_LDA(At, 0, 0); PG8_STAGE(PG8_SA(1, 1), a1 + hstepA, voffA);
            PG8_WAIT_V(8); PG8_WAIT_L(0); PG8_BAR; PG8_MMA(0, 0, At, B0); PG8_MMA(0, 1, At, B1); PG8_BAR; PG8_SCHED;
            PG8_LDA(At, 0, 1); PG8_STAGE(PG8_SB(0, 0), b2, voffB); PG8_STAGE(PG8_SB(0, 1), b2 + hstepB, voffB); PG8_STAGE(PG8_SA(0, 0), a2, voffA);
            PG8_WAIT_V(8); PG8_WAIT_L(0); PG8_BAR; PG8_MMA(1, 0, At, B0); PG8_MMA(1, 1, At, B1); PG8_BAR; PG8_SCHED;
            PG8_LDB(B0, 1, 0); PG8_LDB(B1, 1, 1); PG8_SCHED; PG8_LDA(At, 1, 0); PG8_STAGE(PG8_SA(0, 1), a2 + hstepA, voffA);
            PG8_WAIT_V(8); PG8_WAIT_L(0); PG8_BAR; PG8_MMA(0, 0, At, B0); PG8_MMA(0, 1, At, B1); PG8_BAR; PG8_SCHED;
            PG8_LDA(At, 1, 1); PG8_STAGE(PG8_SB(1, 0), b3, voffB); PG8_STAGE(PG8_SB(1, 1), b3 + hstepB, voffB); PG8_STAGE(PG8_SA(1, 0), a3, voffA);
            PG8_WAIT_V(8); PG8_WAIT_L(0); PG8_BAR; PG8_MMA(1, 0, At, B0); PG8_MMA(1, 1, At, B1); PG8_BAR; PG8_SCHED;
            } else {
            PG8_LDB(B0, 0, 0); PG8_SCHED; PG8_LDA(At, 0, 0); PG8_STAGE(PG8_SA(1, 1), a1 + hstepA, voffA);
            PG8_WAIT_L(8); PG8_BAR; PG8_WAIT_L(0); PG8_MMA(0, 0, At, B0); PG8_BAR; PG8_SCHED;
            PG8_LDB(B1, 0, 1); PG8_STAGE(PG8_SB(0, 0), b2, voffB);
            PG8_BAR; PG8_WAIT_L(0); PG8_MMA(0, 1, At, B1); PG8_BAR;
            PG8_LDA(At, 0, 1); PG8_STAGE(PG8_SA(0, 0), a2, voffA);
            PG8_BAR; PG8_WAIT_L(0); PG8_MMA(1, 0, At, B0); PG8_BAR; PG8_SCHED;
            PG8_STAGE(PG8_SB(0, 1), b2 + hstepB, voffB);
            PG8_WAIT_V(6); PG8_BAR; PG8_MMA(1, 1, At, B1); PG8_BAR;
            PG8_LDB(B0, 1, 0); PG8_SCHED; PG8_LDA(At, 1, 0); PG8_STAGE(PG8_SA(0, 1), a2 + hstepA, voffA);
            PG8_WAIT_L(8); PG8_BAR; PG8_WAIT_L(0); PG8_MMA(0, 0, At, B0); PG8_BAR; PG8_SCHED;
            PG8_LDB(B1, 1, 1); PG8_STAGE(PG8_SB(1, 0), b3, voffB);
            PG8_BAR; PG8_WAIT_L(0); PG8_MMA(0, 1, At, B1); PG8_BAR;
            PG8_LDA(At, 1, 1); PG8_STAGE(PG8_SA(1, 0), a3, voffA);
            PG8_BAR; PG8_WAIT_L(0); PG8_MMA(1, 0, At, B0); PG8_BAR; PG8_SCHED;
            PG8_STAGE(PG8_SB(1, 1), b3 + hstepB, voffB);
            PG8_WAIT_V(6); PG8_BAR; PG8_MMA(1, 1, At, B1); PG8_BAR;
            }
        }
        if constexpr (ALIGN_EPI) { if (wr == 0) PG8_BAR; }
        if constexpr (!Epi::AFTER_DRAIN) { E(acc, cur, wr, wc, fr, fq); S.done(cur); }
        if (!has_next) break;
#pragma unroll
        for (int a = 0; a < 2; ++a)
#pragma unroll
            for (int b = 0; b < 2; ++b)
#pragma unroll
                for (int m = 0; m < 4; ++m)
#pragma unroll
                    for (int n = 0; n < 2; ++n) acc[a][b][m][n] = (f32x4){0.f, 0.f, 0.f, 0.f};
        cur = nxt; cA = nA; cB = nB; ++ui;
        if constexpr (ALIGN_EPI) { if (wr == 1) PG8_BAR; }
    }
    PG8_WAIT_V(0);
    if constexpr (!ALIGN_EPI) { if (wr == 0) PG8_BAR; }
    PG8_BAR;
    if constexpr (Epi::AFTER_DRAIN) { E.fused(acc, cur, wr, wc, fr, fq, lds, wid, lane); S.done(cur); }
#undef PG8_SA
#undef PG8_SB
#undef PG8_STAGE
#undef PG8_LDA
#undef PG8_LDB
#undef PG8_MMA
#undef PG8_WAIT_V
#undef PG8_WAIT_L
#undef PG8_BAR
#undef PG8_SCHED
}
}

namespace {
typedef unsigned short bf16_t;
#define LAS __attribute__((address_space(3)))
constexpr int D = 2048, BP = 4, TP = 2048, BS = 128, TS = 4, PAST = 2048;
constexpr int MP = BP * TP, MS = BS * TS, M = MP + MS;
constexpr int PW = 1024;
constexpr int INW = 7728, ZQ = 1024, ZKV = 2048, ZNG = 3584, ZMG = 3632;
constexpr int NIN = 7680;
constexpr int FF = 5632;
constexpr int NB = BP + BS;
constexpr float EPS = 1e-6f;

constexpr size_t O_YP = 0;
constexpr size_t O_YS = O_YP + (size_t)MP * D;
constexpr size_t O_KVP = O_YS + (size_t)MS * D;
constexpr size_t O_KVS = O_KVP + (size_t)MP * 1024;
constexpr size_t O_WINP = O_KVS + (size_t)MS * 1024;
constexpr size_t O_WINS = O_WINP + (size_t)BP * 512 * 512;
constexpr size_t O_POOLP = O_WINS + (size_t)BS * 512 * 512;
constexpr size_t O_POOLS = O_POOLP + (size_t)BP * 15 * 1024;
constexpr size_t O_CONVP = O_POOLS + (size_t)BS * 15 * 1024;
constexpr size_t O_CONVS = O_CONVP + (size_t)BP * 2 * FF;
constexpr size_t O_END = O_CONVS + (size_t)BS * 2 * FF;

constexpr size_t W_POOLIN = 0;
constexpr size_t W_H1 = W_POOLIN + (size_t)M * PW;
constexpr size_t W_NGS = W_H1 + (size_t)M * D;
constexpr size_t W_C1 = W_NGS + (size_t)M * 48;
constexpr size_t W_FIXV = W_C1 + 128;
constexpr size_t W_FIXG = W_FIXV + (size_t)512 * FF;
constexpr size_t W_TAILG = W_FIXG + (size_t)512 * FF;
constexpr size_t W_SLAB = W_TAILG + (size_t)256 * FF;
constexpr size_t W_SLABM = W_SLAB + (size_t)11 * MS * D;
constexpr size_t W_END = W_SLABM + (size_t)8 * MS * D;
constexpr size_t H_UB = 0;
constexpr size_t H_XCAT = H_UB + (size_t)M * D;
constexpr size_t H_MERGEDB = H_XCAT + (size_t)M * D;
constexpr size_t H_U2B = H_MERGEDB + (size_t)M * D;
constexpr size_t H_UPB = H_U2B + (size_t)M * D;
constexpr size_t H_ACTB = H_UPB + (size_t)M * 2 * FF;
constexpr size_t H_GATEB = H_ACTB + (size_t)M * FF;
constexpr size_t H_WTIN = H_GATEB + (size_t)M * 4096;
constexpr size_t H_WTNG = H_WTIN + (size_t)NIN * D;
constexpr size_t H_WTPN = H_WTNG + (size_t)64 * D;
constexpr size_t H_WTOUT = H_WTPN + (size_t)D * D;
constexpr size_t H_WTUP = H_WTOUT + (size_t)D * D;
constexpr size_t H_WTDOWN = H_WTUP + (size_t)2 * FF * D;
constexpr size_t H_QB = H_WTDOWN + (size_t)D * FF;
constexpr size_t H_KVB = H_QB + (size_t)M * 1024;
constexpr size_t H_KCB = H_KVB + (size_t)4 * M * 256;
constexpr size_t H_VCB = H_KCB + (size_t)NB * 64 * 256;
constexpr size_t H_W1F = H_VCB + (size_t)NB * 64 * 256;
constexpr size_t H_W2F = H_W1F + (size_t)2 * 64 * 4 * 512;
constexpr size_t H_TB = H_W2F + (size_t)2 * 2 * 4 * 512;
constexpr size_t H_END = H_TB + (size_t)MP * D;
constexpr size_t WS_CTL_BYTES = 1u << 20;
constexpr size_t WS_F32_OFF = WS_CTL_BYTES;
constexpr size_t WS_H_OFF = WS_F32_OFF + ((W_END * 4 + 255) / 256) * 256;
constexpr size_t WS_TOTAL = WS_H_OFF + H_END * 2;

__device__ const unsigned char BUCKET[128] = {0, 1, 2, 3, 4, 5, 6, 7, 8, 9, 10, 11, 12, 13, 14, 15, 16, 16, 16, 17, 17, 18, 18, 18, 19, 19, 19, 20, 20, 20, 20, 21, 21, 21, 21, 22, 22, 22, 22, 22, 23, 23, 23, 23, 23, 23, 24, 24, 24, 24, 24, 24, 25, 25, 25, 25, 25, 25, 25, 26, 26, 26, 26, 26, 26, 26, 26, 27, 27, 27, 27, 27, 27, 27, 27, 27, 27, 28, 28, 28, 28, 28, 28, 28, 28, 28, 28, 29, 29, 29, 29, 29, 29, 29, 29, 29, 29, 29, 29, 30, 30, 30, 30, 30, 30, 30, 30, 30, 30, 30, 30, 30, 30, 31, 31, 31, 31, 31, 31, 31, 31, 31, 31, 31, 31, 31, 31, 31};

struct Ptrs {
    const float *xp, *xs, *cache; const int* pt; const float *swin, *spool, *sconv, *g_pre, *w_in, *pe_k, *w1_k, *w2_k, *pe_v, *w1_v, *w2_v, *rel_bias, *w_pgrp, *pool_scale,
        *w_pproj, *w_nproj, *w_out, *g_pmix, *g_pffn, *w_up, *conv_w, *conv_b, *w_down, *g_postffn;
    float* out; float* ws;
    bf16_t *ub, *xcat, *mergedb, *u2b, *upb, *actb, *gateb, *wt_in, *wt_ng, *wt_pn, *wt_out, *wt_up, *wt_down, *qb, *kvb, *kcb, *vcb, *w1f, *w2f, *tb; float *ngs, *c1;
};

__device__ __forceinline__ unsigned f2bf(float f) { unsigned u = __builtin_bit_cast(unsigned, f); return (u + 0x7fffu + ((u >> 16) & 1u)) >> 16; }
#if defined(__HIP_DEVICE_COMPILE__)
typedef float pk_f32x2 __attribute__((ext_vector_type(2))); typedef __bf16 pk_bf16x2 __attribute__((ext_vector_type(2)));
__device__ __forceinline__ unsigned pk2(float lo, float hi) { const pk_f32x2 v = {lo, hi}; const pk_bf16x2 b = __builtin_convertvector(v, pk_bf16x2); return __builtin_bit_cast(unsigned, b); }
#else
__device__ __forceinline__ unsigned pk2(float lo, float hi) { return f2bf(lo) | (f2bf(hi) << 16); }
#endif
typedef unsigned v4u __attribute__((ext_vector_type(4)));
__device__ __forceinline__ void st_bf16x4(bf16_t* p, float4 v) { uint2 o; o.x = pk2(v.x, v.y); o.y = pk2(v.z, v.w); *(uint2*)p = o; }

__device__ __forceinline__ float wave_sum(float v) {
#pragma unroll
    for (int o = 1; o < 64; o <<= 1) v += __shfl_xor(v, o);
    return v;
}
__device__ __forceinline__ float wave_max(float v) {
#pragma unroll
    for (int o = 1; o < 64; o <<= 1) v = fmaxf(v, __shfl_xor(v, o));
    return v;
}
__device__ __forceinline__ float gelu_tanh(float x) { const float y2 = 1.5957691216057308f * (x + 0.044715f * x * x * x); return x * __builtin_amdgcn_rcpf(1.0f + __builtin_amdgcn_exp2f(-y2 * 1.4426950408889634f)); }
__device__ __forceinline__ float sigmoidf(float x) { return 1.0f / (1.0f + expf(-x)); }
__device__ __forceinline__ const float* xrow(const Ptrs& P, int m) { return m < MP ? P.xp + (size_t)m * D : P.xs + (size_t)(m - MP) * D; }

struct F8 { float v[8]; };
__device__ __forceinline__ F8 ld8f(const float* p) { const float4 a = *(const float4*)p, b = *(const float4*)(p + 4); F8 r; r.v[0] = a.x; r.v[1] = a.y; r.v[2] = a.z; r.v[3] = a.w; r.v[4] = b.x; r.v[5] = b.y; r.v[6] = b.z; r.v[7] = b.w; return r; }
__device__ __forceinline__ F8 ld8h(const bf16_t* p) { const v4u t = *(const v4u*)p; F8 r; r.v[0] = __builtin_bit_cast(float, t.x << 16); r.v[1] = __builtin_bit_cast(float, t.x & 0xffff0000u); r.v[2] = __builtin_bit_cast(float, t.y << 16); r.v[3] = __builtin_bit_cast(float, t.y & 0xffff0000u);
    r.v[4] = __builtin_bit_cast(float, t.z << 16); r.v[5] = __builtin_bit_cast(float, t.z & 0xffff0000u); r.v[6] = __builtin_bit_cast(float, t.w << 16); r.v[7] = __builtin_bit_cast(float, t.w & 0xffff0000u); return r; }
__device__ __forceinline__ void st8f(float* p, const F8& r) { *(float4*)p = make_float4(r.v[0], r.v[1], r.v[2], r.v[3]); *(float4*)(p + 4) = make_float4(r.v[4], r.v[5], r.v[6], r.v[7]); }
__device__ __forceinline__ void st8h(bf16_t* p, const F8& r) { v4u t; t.x = pk2(r.v[0], r.v[1]); t.y = pk2(r.v[2], r.v[3]); t.z = pk2(r.v[4], r.v[5]); t.w = pk2(r.v[6], r.v[7]); *(v4u*)p = t; }
template <int MODE, int U, int NS>
__device__ __forceinline__ void rms_rows(const Ptrs& P, int row_lo, int row_hi, int gwave, int nwaves, int lane) {
    for (int m0 = row_lo + gwave; m0 < row_hi; m0 += U * nwaves) {
        F8 v[U][4], a[U][4]; bool ok[U]; int mm[U];
#pragma unroll
        for (int u = 0; u < U; ++u) { const int m = m0 + u * nwaves; ok[u] = m < row_hi; mm[u] = ok[u] ? m : m0;
            const float* aux = xrow(P, mm[u]); const bf16_t* h1b = (const bf16_t*)(P.ws + W_H1) + (size_t)mm[u] * D;
#pragma unroll
            for (int j = 0; j < 4; ++j) { const int c = 8 * (64 * j + lane);
                if (MODE == 0) v[u][j] = ld8f(xrow(P, mm[u]) + c);
                else if (NS > 0) v[u][j] = ld8h((const bf16_t*)(P.ws + W_SLAB) + (size_t)(mm[u] - MP) * D + c);
                else v[u][j] = ld8h(P.tb + (size_t)mm[u] * D + c);
                if (MODE == 1) a[u][j] = ld8f(aux + c); else if (MODE == 2) a[u][j] = ld8h(h1b + c); }
#pragma unroll 5
            for (int k = 1; k < NS; ++k)
#pragma unroll
                for (int j = 0; j < 4; ++j) { const F8 t = ld8h((const bf16_t*)(P.ws + W_SLAB) + (size_t)k * MS * D + (size_t)(mm[u] - MP) * D + 8 * (64 * j + lane));
#pragma unroll
                    for (int e = 0; e < 8; ++e) v[u][j].v[e] += t.v[e]; } }
#pragma unroll
        for (int u = 0; u < U; ++u) {
            float ss = 0.f;
#pragma unroll
            for (int j = 0; j < 4; ++j)
#pragma unroll
                for (int e = 0; e < 8; ++e) ss += v[u][j].v[e] * v[u][j].v[e];
            ss = wave_sum(ss);
            const float r = rsqrtf(ss * (1.0f / D) + EPS); const int m = mm[u];
            if (MODE == 0) {
                if (ok[u]) {
#pragma unroll
                    for (int j = 0; j < 4; ++j) { const int c = 8 * (64 * j + lane); const F8 g = ld8f(P.g_pre + c); F8 o;
#pragma unroll
                        for (int e = 0; e < 8; ++e) o.v[e] = v[u][j].v[e] * r * g.v[e];
                        st8h(P.ub + (size_t)m * D + c, o); } }
            } else if (MODE == 1) {
                float s2 = 0.f;
#pragma unroll
                for (int j = 0; j < 4; ++j) { const int c = 8 * (64 * j + lane); const F8 g = ld8f(P.g_pmix + c); F8 o;
#pragma unroll
                    for (int e = 0; e < 8; ++e) { o.v[e] = a[u][j].v[e] + v[u][j].v[e] * r * g.v[e]; s2 += o.v[e] * o.v[e]; }
                    if (ok[u]) st8h((bf16_t*)(P.ws + W_H1) + (size_t)m * D + c, o); v[u][j] = o; }
                s2 = wave_sum(s2); const float r2 = rsqrtf(s2 * (1.0f / D) + EPS);
                if (ok[u]) {
#pragma unroll
                    for (int j = 0; j < 4; ++j) { const int c = 8 * (64 * j + lane); const F8 g = ld8f(P.g_pffn + c); F8 o;
#pragma unroll
                        for (int e = 0; e < 8; ++e) o.v[e] = v[u][j].v[e] * r2 * g.v[e];
                        st8h(P.u2b + (size_t)m * D + c, o); } }
            } else {
                float* orow = m < MP ? P.out + O_YP + (size_t)m * D : P.out + O_YS + (size_t)(m - MP) * D;
                if (ok[u]) {
#pragma unroll
                    for (int j = 0; j < 4; ++j) { const int c = 8 * (64 * j + lane); const F8 g = ld8f(P.g_postffn + c); F8 o;
#pragma unroll
                        for (int e = 0; e < 8; ++e) o.v[e] = a[u][j].v[e] + v[u][j].v[e] * r * g.v[e];
                        st8f(orow + c, o); } }
            }
        }
    }
}
template <int MODE>
__device__ __forceinline__ void rms_stage(const Ptrs& P, int gwave, int nwaves, int lane) {
    if (MODE == 0) rms_rows<0, 2, 0>(P, 0, M, gwave, nwaves, lane);
    else { rms_rows<MODE, 2, 0>(P, 0, MP, gwave, nwaves, lane);
           rms_rows<MODE, 1, (MODE == 1 ? 8 : 11)>(P, MP, M, (gwave & 7) * (nwaves >> 3) + (gwave >> 3), nwaves, lane); }
}

struct TrItem { const float* src; int ldw; bf16_t* dst; int K; };
__device__ __forceinline__ TrItem tr_decode(const Ptrs& P, int it, int lane) {
    constexpr int I_A = (D / 64) * (3584 / 32), I_MG = (D / 64) * (4096 / 32), I_N = (1024 / 64) * (D / 32), I_O = (D / 64) * (D / 32), I_UP = (D / 64) * (2 * FF / 32);
    const float* W; int ldw, nblk, K; bf16_t* WT; int r = it; bool upmap = false;
    if (r < I_A) { W = P.w_in; ldw = INW; nblk = 3584 / 32; K = D; WT = P.wt_in; }
    else if ((r -= I_A) < I_MG) { W = P.w_in + ZMG; ldw = INW; nblk = 4096 / 32; K = D; WT = P.wt_in + (size_t)3584 * D; }
    else if ((r -= I_MG) < I_N) { W = P.w_nproj; ldw = D; nblk = D / 32; K = D; WT = P.wt_pn + 1024; }
    else if ((r -= I_N) < I_O) { W = P.w_out; ldw = D; nblk = D / 32; K = D; WT = P.wt_out; }
    else if ((r -= I_O) < I_UP) { W = P.w_up; ldw = 2 * FF; nblk = 2 * FF / 32; K = D; WT = P.wt_up; upmap = true; }
    else { r -= I_UP; W = P.w_down; ldw = D; nblk = D / 32; K = FF; WT = P.wt_down; }
    const int kb = r / nblk, nb = r % nblk, k0 = 64 * kb, n0 = 32 * nb;
    int nd = n0;
    if (upmap) { const int half = n0 >= FF, f0 = half ? n0 - FF : n0; nd = (f0 >> 7) * 256 + half * 128 + (f0 & 127); }
    TrItem t; t.src = W + (size_t)(k0 + (lane >> 3)) * ldw + n0 + (lane & 7) * 4; t.ldw = ldw; t.dst = WT + (size_t)nd * K + k0; t.K = K; return t;
}
constexpr int TR_P0 = (D / 64) * (3584 / 32) + (D / 64) * (4096 / 32) + (1024 / 64) * (D / 32), TR_O = TR_P0 + (D / 64) * (D / 32), TR_UP = TR_O + (D / 64) * (2 * FF / 32), TR_ALL = TR_UP + (FF / 64) * (D / 32);
constexpr int TR_SLOTA = TR_O + 5120;
__device__ __forceinline__ void prologue_transposes(const Ptrs& P, unsigned char* lds, int it_lo, int it_hi, int gwave, int nwaves, int wave, int lane) {
    LAS float* scr = (LAS float*)((LAS unsigned char*)lds + wave * 16384);
    const int NITEMS = it_hi;
    const int kk = lane >> 3, n4 = (lane & 7) * 4, c = lane & 7;
    int it = it_lo + gwave; if (it >= NITEMS) return;
    TrItem cur = tr_decode(P, it, lane);
    float4 x[8];
#pragma unroll
    for (int i = 0; i < 8; ++i) x[i] = *(const float4*)(cur.src + (size_t)(8 * i) * cur.ldw);
    for (;;) {
        const int itn = it + nwaves; const bool more = itn < NITEMS;
        const TrItem nxt = tr_decode(P, more ? itn : it, lane);
        float4 xn[8];
#pragma unroll
        for (int i = 0; i < 8; ++i) xn[i] = *(const float4*)(nxt.src + (size_t)(8 * i) * nxt.ldw);
#pragma unroll
        for (int i = 0; i < 8; ++i) { LAS float* d = scr + (kk + 8 * i) * 33 + n4; d[0] = x[i].x; d[1] = x[i].y; d[2] = x[i].z; d[3] = x[i].w; }
        asm volatile("s_waitcnt lgkmcnt(0)" ::: "memory");
#pragma unroll
        for (int j = 0; j < 4; ++j) { const int n = (lane >> 3) + 8 * j; const LAS float* sp = scr + (8 * c) * 33 + n;
            v4u o; o.x = pk2(sp[0 * 33], sp[1 * 33]); o.y = pk2(sp[2 * 33], sp[3 * 33]); o.z = pk2(sp[4 * 33], sp[5 * 33]); o.w = pk2(sp[6 * 33], sp[7 * 33]);
            *(v4u*)(cur.dst + (size_t)n * cur.K + 8 * c) = o; }
        asm volatile("s_waitcnt lgkmcnt(0)" ::: "memory");
        if (!more) break;
#pragma unroll
        for (int i = 0; i < 8; ++i) x[i] = xn[i];
        cur = nxt; it = itn;
    }
}
__device__ __forceinline__ void prologue_ng(const Ptrs& P, size_t gtid, size_t nthr) {
    for (size_t i = gtid; i < (size_t)64 * D; i += nthr) { const int n = (int)(i >> 11), k = (int)(i & 2047); P.wt_ng[i] = (bf16_t)(n < 48 ? f2bf(P.w_in[(size_t)k * INW + ZNG + n]) : 0u); }
}
__device__ __forceinline__ void prologue_wprime(const Ptrs& P, float* lds, int bid, int nblk, int tid) {
    float (*As)[68] = (float (*)[68])lds; float (*Bs)[132] = (float (*)[132])(lds + 16 * 68);
    const int ty = tid >> 5, tx = tid & 31;
    for (int tile = bid; tile < 256; tile += nblk) {
        const int gi = tile >> 6, tm = (tile >> 4) & 3, tn = tile & 15;
        const float* A = P.w_pgrp + (size_t)gi * 65536; const float* B = P.w_pproj + (size_t)gi * 256 * D; const float* ks = P.pool_scale + gi * 256;
        float acc[4][4];
#pragma unroll
        for (int i = 0; i < 4; ++i)
#pragma unroll
            for (int j = 0; j < 4; ++j) acc[i][j] = 0.f;
        const int ar = (tid >> 2) & 63, akq = (tid & 3) * 4; const int bk = tid >> 5, bn = (tid & 31) * 4;
        for (int k0 = 0; k0 < 256; k0 += 16) {
            float4 av = *(const float4*)(A + (size_t)(tm * 64 + ar) * 256 + k0 + akq); const float4 sv = *(const float4*)(ks + k0 + akq);
            av.x *= sv.x; av.y *= sv.y; av.z *= sv.z; av.w *= sv.w;
            const float4 bv = *(const float4*)(B + (size_t)(k0 + bk) * D + tn * 128 + bn);
            __syncthreads();
            if (tid < 256) { As[akq + 0][ar] = av.x; As[akq + 1][ar] = av.y; As[akq + 2][ar] = av.z; As[akq + 3][ar] = av.w; }
            *(float4*)&Bs[bk][bn] = bv;
            __syncthreads();
#pragma unroll
            for (int k = 0; k < 16; ++k) {
                const float4 a0 = *(const float4*)&As[k][ty * 4], b = *(const float4*)&Bs[k][tx * 4];
                const float a[4] = {a0.x, a0.y, a0.z, a0.w}; const float bb[4] = {b.x, b.y, b.z, b.w};
#pragma unroll
                for (int i = 0; i < 4; ++i)
#pragma unroll
                    for (int j = 0; j < 4; ++j) acc[i][j] = fmaf(a[i], bb[j], acc[i][j]);
            }
        }
#pragma unroll
        for (int j = 0; j < 4; ++j) { const int col = tn * 128 + tx * 4 + j; const int row = gi * 256 + tm * 64 + ty * 4;
            uint2 o; o.x = pk2(acc[0][j], acc[1][j]); o.y = pk2(acc[2][j], acc[3][j]); *(uint2*)(P.wt_pn + (size_t)col * D + row) = o; }
    }
}
typedef short bf16x8_t __attribute__((ext_vector_type(8)));
typedef float f32x4_t __attribute__((ext_vector_type(4)));
__device__ __forceinline__ void ng_stage(const Ptrs& P, int bid, int nblk, int wave, int lane) {
    const int r16 = lane & 15, kq = lane >> 4;
    for (int task = wave * nblk + bid; task < M / 16; task += 8 * nblk) {
        const bf16_t* arow = P.ub + (size_t)(task * 16 + r16) * D + 8 * kq;
        const bf16_t* brow = P.wt_ng + (size_t)r16 * D + 8 * kq;
        f32x4_t acc[3] = {{0.f, 0.f, 0.f, 0.f}, {0.f, 0.f, 0.f, 0.f}, {0.f, 0.f, 0.f, 0.f}};
#pragma unroll 4
        for (int ks = 0; ks < D / 32; ++ks) {
            const bf16x8_t a = *(const bf16x8_t*)(arow + 32 * ks);
#pragma unroll
            for (int nt = 0; nt < 3; ++nt) { const bf16x8_t b = *(const bf16x8_t*)(brow + (size_t)nt * 16 * D + 32 * ks); acc[nt] = __builtin_amdgcn_mfma_f32_16x16x32_bf16(a, b, acc[nt], 0, 0, 0); }
        }
#pragma unroll
        for (int nt = 0; nt < 3; ++nt)
#pragma unroll
            for (int r = 0; r < 4; ++r) P.ngs[(size_t)(task * 16 + kq * 4 + r) * 48 + nt * 16 + r16] = sigmoidf(acc[nt][r]);
    }
}
template <int R, bool PROMPT>
__device__ __forceinline__ void compress_mfma(const Ptrs& P, int gwave, int nwaves, int lane) {
    const int r16 = lane & 15, kq = lane >> 4, n4 = r16 >> 2, g = r16 & 3;
    const int ntask = (PROMPT ? BP * 16 : BS * 16) / R * 2;
    for (int task = gwave; task < ntask; task += nwaves) {
        const int slot = task & 1, pgp = task >> 1;
        const float* rowp[R]; int obase[R]; int stride;
#pragma unroll
        for (int rr = 0; rr < R; ++rr) { const int pgi = pgp * R + rr, b = pgi >> 4, pg = pgi & 15;
            if (PROMPT) { stride = 1024; rowp[rr] = P.out + O_KVP + (size_t)(b * TP + pg * 128 + n4 * 32) * 1024 + slot * 256 + g * 64 + 8 * kq; obase[rr] = (((b) * 64 + pg * 4 + n4) * 4 + g) * 64; }
            else { stride = 1024; const int page = P.pt[b * 16 + pg]; rowp[rr] = P.cache + ((size_t)page * 128 + n4 * 32) * 1024 + slot * 256 + g * 64 + 8 * kq; obase[rr] = (((BP + b) * 64 + pg * 4 + n4) * 4 + g) * 64; } }
        f32x4_t acc[R][4];
#pragma unroll
        for (int rr = 0; rr < R; ++rr)
#pragma unroll
            for (int nt = 0; nt < 4; ++nt) acc[rr][nt] = (f32x4_t){0.f, 0.f, 0.f, 0.f};
        const bf16_t* w1f = P.w1f + (size_t)slot * 64 * 4 * 512 + lane * 8;
#pragma unroll 4
        for (int ks = 0; ks < 64; ++ks) {
            bf16x8_t a[4];
#pragma unroll
            for (int nt = 0; nt < 4; ++nt) a[nt] = *(const bf16x8_t*)(w1f + (size_t)(ks * 4 + nt) * 512);
            const size_t off = (size_t)(ks >> 1) * stride + (ks & 1) * 32;
#pragma unroll
            for (int rr = 0; rr < R; ++rr) {
                const float4 x0 = *(const float4*)(rowp[rr] + off), x1 = *(const float4*)(rowp[rr] + off + 4);
                v4u t; t.x = pk2(x0.x, x0.y); t.y = pk2(x0.z, x0.w); t.z = pk2(x1.x, x1.y); t.w = pk2(x1.z, x1.w);
                const bf16x8_t bfr = __builtin_bit_cast(bf16x8_t, t);
#pragma unroll
                for (int nt = 0; nt < 4; ++nt) acc[rr][nt] = __builtin_amdgcn_mfma_f32_16x16x32_bf16(a[nt], bfr, acc[rr][nt], 0, 0, 0);
            }
        }
        const float* c1 = P.c1 + slot * 64 + 4 * kq;
        const bf16_t* w2f = P.w2f + (size_t)slot * 2 * 4 * 512 + lane * 8;
#pragma unroll
        for (int rr = 0; rr < R; ++rr) {
            bf16x8_t hb[2];
#pragma unroll
            for (int k2 = 0; k2 < 2; ++k2) { float hv[8];
#pragma unroll
                for (int j = 0; j < 8; ++j) { const int nt = 2 * k2 + (j >> 2); hv[j] = gelu_tanh(acc[rr][nt][j & 3] + c1[16 * nt + (j & 3)]); }
                v4u t; t.x = pk2(hv[0], hv[1]); t.y = pk2(hv[2], hv[3]); t.z = pk2(hv[4], hv[5]); t.w = pk2(hv[6], hv[7]); hb[k2] = __builtin_bit_cast(bf16x8_t, t); }
#pragma unroll
            for (int ft = 0; ft < 4; ++ft) { f32x4_t o2 = (f32x4_t){0.f, 0.f, 0.f, 0.f};
#pragma unroll
                for (int k2 = 0; k2 < 2; ++k2) o2 = __builtin_amdgcn_mfma_f32_16x16x32_bf16(*(const bf16x8_t*)(w2f + (size_t)(k2 * 4 + ft) * 512), hb[k2], o2, 0, 0, 0);
                const int oi = obase[rr] + 16 * ft + 4 * kq;
                uint2 w; w.x = pk2(o2[0], o2[1]); w.y = pk2(o2[2], o2[3]); *(uint2*)((slot ? P.vcb : P.kcb) + oi) = w; }
        }
    }
}
__device__ __forceinline__ void compress_sample_lds(const Ptrs& P, LAS unsigned char* L, int bid, int nblk, int wave, int lane, int tid) {
    constexpr int R = 2, NTASK = BS * 16 / R * 2;
    const int r16 = lane & 15, kq = lane >> 4, n4 = r16 >> 2, g = r16 & 3;
    for (int base = bid * 8; base < NTASK; base += nblk * 8) {
        const int task = base + wave; const bool valid = task < NTASK; const int tk = valid ? task : NTASK - 2 + (wave & 1);
        const int slot = tk & 1, pgp = tk >> 1;
        const float* rowp[R];
#pragma unroll
        for (int rr = 0; rr < R; ++rr) { const int pgi = pgp * R + rr, b = pgi >> 4, pg = pgi & 15; const int page = P.pt[b * 16 + pg];
            rowp[rr] = P.cache + ((size_t)page * 128 + n4 * 32) * 1024 + slot * 256 + g * 64 + 8 * kq; }
        f32x4_t acc[R][4];
#pragma unroll
        for (int rr = 0; rr < R; ++rr)
#pragma unroll
            for (int nt = 0; nt < 4; ++nt) acc[rr][nt] = (f32x4_t){0.f, 0.f, 0.f, 0.f};
        const bf16_t* wsrc0 = P.w1f + (size_t)tid * 8;
        v4u wr[4];
#pragma unroll
        for (int c = 0; c < 4; ++c) wr[c] = *(const v4u*)(wsrc0 + (size_t)((c >> 1) * 64) * 4 * 512 + (c & 1) * 4096);
        __syncthreads();
#pragma unroll
        for (int c = 0; c < 4; ++c) *(LAS v4u*)(L + (c >> 1) * 16384 + (c & 1) * 8192 + tid * 16) = wr[c];
        __syncthreads();
        for (int kb = 0; kb < 16; ++kb) {
            const int kn = (kb < 15) ? kb + 1 : kb;
#pragma unroll
            for (int c = 0; c < 4; ++c) wr[c] = *(const v4u*)(wsrc0 + (size_t)((c >> 1) * 64 + 4 * kn) * 4 * 512 + (c & 1) * 4096);
            float4 x[4][R][2];
#pragma unroll
            for (int q = 0; q < 4; ++q)
#pragma unroll
                for (int rr = 0; rr < R; ++rr) { const size_t off = (size_t)(2 * kb + (q >> 1)) * 1024 + (q & 1) * 32; x[q][rr][0] = *(const float4*)(rowp[rr] + off); x[q][rr][1] = *(const float4*)(rowp[rr] + off + 4); }
            const LAS unsigned char* wb = L + (kb & 1) * 32768 + slot * 16384 + lane * 16;
#pragma unroll
            for (int q = 0; q < 4; ++q) {
                bf16x8_t a[4];
#pragma unroll
                for (int nt = 0; nt < 4; ++nt) a[nt] = *(const LAS bf16x8_t*)(wb + (q * 4 + nt) * 1024);
#pragma unroll
                for (int rr = 0; rr < R; ++rr) {
                    const float4 x0 = x[q][rr][0], x1 = x[q][rr][1];
                    v4u t; t.x = pk2(x0.x, x0.y); t.y = pk2(x0.z, x0.w); t.z = pk2(x1.x, x1.y); t.w = pk2(x1.z, x1.w);
                    const bf16x8_t bfr = __builtin_bit_cast(bf16x8_t, t);
#pragma unroll
                    for (int nt = 0; nt < 4; ++nt) acc[rr][nt] = __builtin_amdgcn_mfma_f32_16x16x32_bf16(a[nt], bfr, acc[rr][nt], 0, 0, 0);
                }
            }
#pragma unroll
            for (int c = 0; c < 4; ++c) *(LAS v4u*)(L + ((kb + 1) & 1) * 32768 + (c >> 1) * 16384 + (c & 1) * 8192 + tid * 16) = wr[c];
            __syncthreads();
        }
        int l2; asm volatile("v_mbcnt_lo_u32_b32 %0, -1, 0\n\tv_mbcnt_hi_u32_b32 %0, -1, %0" : "=v"(l2) :: "memory");
        const int kq2 = l2 >> 4, r2 = l2 & 15;
        const float* c1 = P.c1 + slot * 64 + 4 * kq2;
        const bf16_t* w2f = P.w2f + (size_t)slot * 2 * 4 * 512 + l2 * 8;
#pragma unroll
        for (int rr = 0; rr < R; ++rr) {
            const int pgi = pgp * R + rr, b = pgi >> 4, pg = pgi & 15; const int ob = (((BP + b) * 64 + pg * 4 + (r2 >> 2)) * 4 + (r2 & 3)) * 64;
            bf16x8_t hb[2];
#pragma unroll
            for (int k2 = 0; k2 < 2; ++k2) { float hv[8];
#pragma unroll
                for (int j = 0; j < 8; ++j) { const int nt = 2 * k2 + (j >> 2); hv[j] = gelu_tanh(acc[rr][nt][j & 3] + c1[16 * nt + (j & 3)]); }
                v4u t; t.x = pk2(hv[0], hv[1]); t.y = pk2(hv[2], hv[3]); t.z = pk2(hv[4], hv[5]); t.w = pk2(hv[6], hv[7]); hb[k2] = __builtin_bit_cast(bf16x8_t, t); }
#pragma unroll
            for (int ft = 0; ft < 4; ++ft) { f32x4_t o2 = (f32x4_t){0.f, 0.f, 0.f, 0.f};
#pragma unroll
                for (int k2 = 0; k2 < 2; ++k2) o2 = __builtin_amdgcn_mfma_f32_16x16x32_bf16(*(const bf16x8_t*)(w2f + (size_t)(k2 * 4 + ft) * 512), hb[k2], o2, 0, 0, 0);
                const int oi = ob + 16 * ft + 4 * kq2;
                uint2 w; w.x = pk2(o2[0], o2[1]); w.y = pk2(o2[2], o2[3]); if (valid) *(uint2*)((slot ? P.vcb : P.kcb) + oi) = w; }
        }
    }
}
__device__ __forceinline__ void compress_prompt_split(const Ptrs& P, LAS unsigned char* L, int bid, int wave, int lane) {
    const int r16 = lane & 15, kq = lane >> 4, n4 = r16 >> 2, g = r16 & 3;
    const int task = bid * 4 + (wave >> 1), kh = wave & 1, slot = task & 1, pgi = task >> 1, b = pgi >> 4, pg = pgi & 15;
    const float* rowp = P.out + O_KVP + (size_t)(b * TP + pg * 128 + n4 * 32) * 1024 + slot * 256 + g * 64 + 8 * kq;
    f32x4_t acc[4];
#pragma unroll
    for (int nt = 0; nt < 4; ++nt) acc[nt] = (f32x4_t){0.f, 0.f, 0.f, 0.f};
    const bf16_t* w1f = P.w1f + (size_t)slot * 64 * 4 * 512 + lane * 8;
#pragma unroll 4
    for (int kk = 0; kk < 32; ++kk) { const int ks = 32 * kh + kk;
        bf16x8_t a[4];
#pragma unroll
        for (int nt = 0; nt < 4; ++nt) a[nt] = *(const bf16x8_t*)(w1f + (size_t)(ks * 4 + nt) * 512);
        const size_t off = (size_t)(ks >> 1) * 1024 + (ks & 1) * 32;
        const float4 x0 = *(const float4*)(rowp + off), x1 = *(const float4*)(rowp + off + 4);
        v4u t; t.x = pk2(x0.x, x0.y); t.y = pk2(x0.z, x0.w); t.z = pk2(x1.x, x1.y); t.w = pk2(x1.z, x1.w);
        const bf16x8_t bfr = __builtin_bit_cast(bf16x8_t, t);
#pragma unroll
        for (int nt = 0; nt < 4; ++nt) acc[nt] = __builtin_amdgcn_mfma_f32_16x16x32_bf16(a[nt], bfr, acc[nt], 0, 0, 0);
    }
    LAS f32x4_t* X = (LAS f32x4_t*)(L + (wave >> 1) * 4096) + lane;
    __syncthreads();
    if (kh == 1) {
#pragma unroll
        for (int nt = 0; nt < 4; ++nt) X[nt * 64] = acc[nt]; }
    __syncthreads();
    if (kh == 0) {
#pragma unroll
        for (int nt = 0; nt < 4; ++nt) acc[nt] += X[nt * 64];
        const float* c1 = P.c1 + slot * 64 + 4 * kq; const bf16_t* w2f = P.w2f + (size_t)slot * 2 * 4 * 512 + lane * 8;
        const int ob = (((b) * 64 + pg * 4 + n4) * 4 + g) * 64;
        bf16x8_t hb[2];
#pragma unroll
        for (int k2 = 0; k2 < 2; ++k2) { float hv[8];
#pragma unroll
            for (int j = 0; j < 8; ++j) { const int nt = 2 * k2 + (j >> 2); hv[j] = gelu_tanh(acc[nt][j & 3] + c1[16 * nt + (j & 3)]); }
            v4u t; t.x = pk2(hv[0], hv[1]); t.y = pk2(hv[2], hv[3]); t.z = pk2(hv[4], hv[5]); t.w = pk2(hv[6], hv[7]); hb[k2] = __builtin_bit_cast(bf16x8_t, t); }
#pragma unroll
        for (int ft = 0; ft < 4; ++ft) { f32x4_t o2 = (f32x4_t){0.f, 0.f, 0.f, 0.f};
#pragma unroll
            for (int k2 = 0; k2 < 2; ++k2) o2 = __builtin_amdgcn_mfma_f32_16x16x32_bf16(*(const bf16x8_t*)(w2f + (size_t)(k2 * 4 + ft) * 512), hb[k2], o2, 0, 0, 0);
            const int oi = ob + 16 * ft + 4 * kq;
            uint2 w; w.x = pk2(o2[0], o2[1]); w.y = pk2(o2[2], o2[3]); *(uint2*)((slot ? P.vcb : P.kcb) + oi) = w; }
    }
}
__device__ __forceinline__ void prologue_cmp(const Ptrs& P, size_t gtid, size_t nthr, int gwave, int nwaves, int lane) {
    for (size_t i = gtid; i < (size_t)2 * 64 * 4 * 64; i += nthr) { const int ln = (int)(i & 63), nt = (int)((i >> 6) & 3), ks = (int)((i >> 8) & 63), slot = (int)(i >> 14);
        const float* w1 = slot ? P.w1_v : P.w1_k; const int e = 16 * nt + (ln & 15), k0 = 32 * ks + 8 * (ln >> 4);
        v4u t; t.x = pk2(w1[(size_t)(k0 + 0) * 64 + e], w1[(size_t)(k0 + 1) * 64 + e]); t.y = pk2(w1[(size_t)(k0 + 2) * 64 + e], w1[(size_t)(k0 + 3) * 64 + e]);
        t.z = pk2(w1[(size_t)(k0 + 4) * 64 + e], w1[(size_t)(k0 + 5) * 64 + e]); t.w = pk2(w1[(size_t)(k0 + 6) * 64 + e], w1[(size_t)(k0 + 7) * 64 + e]);
        *(v4u*)(P.w1f + i * 8) = t; }
    for (size_t i = gtid; i < (size_t)2 * 2 * 4 * 64; i += nthr) { const int ln = (int)(i & 63), ft = (int)((i >> 6) & 3), k2 = (int)((i >> 8) & 1), slot = (int)(i >> 9);
        const float* w2 = slot ? P.w2_v : P.w2_k; const int f = 16 * ft + (ln & 15); float v[8];
#pragma unroll
        for (int j = 0; j < 8; ++j) v[j] = w2[(size_t)(16 * (2 * k2 + (j >> 2)) + 4 * (ln >> 4) + (j & 3)) * 64 + f];
        v4u t; t.x = pk2(v[0], v[1]); t.y = pk2(v[2], v[3]); t.z = pk2(v[4], v[5]); t.w = pk2(v[6], v[7]); *(v4u*)(P.w2f + i * 8) = t; }
    { const int nblk_ = nwaves >> 3, bid_ = gwave >> 3, wv_ = gwave & 7;
      for (int it = wv_ * nblk_ + bid_; it < 128; it += nwaves) { const int slot = it >> 6, e = it & 63; const float* w1 = slot ? P.w1_v : P.w1_k; const float* pe = slot ? P.pe_v : P.pe_k;
        float sacc = 0.f;
        for (int k0 = 0; k0 < 2048; k0 += 512) { float pv[8], wv[8];
#pragma unroll
            for (int i = 0; i < 8; ++i) { const int k = k0 + 64 * i + lane; pv[i] = pe[k]; wv[i] = w1[(size_t)k * 64 + e]; }
#pragma unroll
            for (int i = 0; i < 8; ++i) sacc = fmaf(pv[i], wv[i], sacc); }
        sacc = wave_sum(sacc); if (lane == 0) P.c1[it] = sacc; } }
}
typedef float f32x16_t __attribute__((ext_vector_type(16)));
typedef short v4i16_t __attribute__((ext_vector_type(4)));
constexpr float LOG2E = 1.4426950408889634f;
constexpr float QSCALE = 0.125f * LOG2E;
constexpr int A_K0 = 0, A_V0 = 8192, A_K1 = 16384, A_V1 = 24576, A_BT = 32768, A_SEL = 34816, A_UNION = 35072, A_IMP = 36864, A_RB = A_IMP + 4 * 64 * 32 * 4, A_END = A_RB + 4 * 4 * 256 * 4;
__device__ __forceinline__ int crow(int r, int hi) { return (r & 3) + 8 * (r >> 2) + 4 * hi; }
__device__ __forceinline__ unsigned cvtpk(float lo, float hi) { unsigned r; asm volatile("v_cvt_pk_bf16_f32 %0, %1, %2" : "=v"(r) : "v"(lo), "v"(hi)); return r; }

__device__ __forceinline__ void qk_tile(f32x16_t& s0, f32x16_t& s1, const LAS unsigned char* kb, const bf16x8_t (&qf)[4], int r32, int hi, float init = 0.f) {
#pragma unroll
    for (int r = 0; r < 16; ++r) { s0[r] = init; s1[r] = init; }
#pragma unroll
    for (int d0 = 0; d0 < 4; ++d0) {
        const int c = 2 * d0 + hi;
        const bf16x8_t a0 = *(const LAS bf16x8_t*)(kb + c * 1024 + ((r32 ^ c) * 16));
        const bf16x8_t a1 = *(const LAS bf16x8_t*)(kb + c * 1024 + 512 + ((r32 ^ c) * 16));
        s0 = __builtin_amdgcn_mfma_f32_32x32x16_bf16(a0, qf[d0], s0, 0, 0, 0);
        s1 = __builtin_amdgcn_mfma_f32_32x32x16_bf16(a1, qf[d0], s1, 0, 0, 0);
    }
}
__device__ __forceinline__ void pv_tile(f32x16_t (&o)[2], const LAS unsigned char* vb, const f32x16_t& p0, const f32x16_t& p1, int lane) {
    bf16x8_t pf[4];
#pragma unroll
    for (int s = 0; s < 4; ++s) {
        const int base = 8 * (s & 1);
        unsigned w[4];
#pragma unroll
        for (int k = 0; k < 4; ++k) w[k] = (s < 2) ? cvtpk(p0[base + 2 * k], p0[base + 2 * k + 1]) : cvtpk(p1[base + 2 * k], p1[base + 2 * k + 1]);
        v4u t; t.x = w[0]; t.y = w[1]; t.z = w[2]; t.w = w[3]; pf[s] = __builtin_bit_cast(bf16x8_t, t);
    }
    const LAS unsigned char* va = vb + ((lane >> 4) & 1) * 32 + (lane & 3) * 8 + (4 * (lane >> 5) + ((lane & 15) >> 2)) * 64;
#pragma unroll
    for (int dd = 0; dd < 2; ++dd)
#pragma unroll
        for (int s = 0; s < 4; ++s) {
            const v4i16_t lo = __builtin_amdgcn_ds_read_tr16_b64_v4i16((LAS v4i16_t*)(va + dd * 4096 + s * 1024));
            const v4i16_t hh = __builtin_amdgcn_ds_read_tr16_b64_v4i16((LAS v4i16_t*)(va + dd * 4096 + s * 1024 + 512));
            const bf16x8_t vf = (bf16x8_t){lo[0], lo[1], lo[2], lo[3], hh[0], hh[1], hh[2], hh[3]};
            o[dd] = __builtin_amdgcn_mfma_f32_32x32x16_bf16(vf, pf[s], o[dd], 0, 0, 0);
        }
}
__device__ __forceinline__ v4u ld_k16(const bf16_t* src, int stride, int wave, int lane) { const int t = wave * 64 + lane; return *(const v4u*)(src + (size_t)(t >> 3) * stride + (t & 7) * 8); }
__device__ __forceinline__ v4u ld_v16(const bf16_t* src, int stride, int tid) { return *(const v4u*)(src + (size_t)(tid >> 3) * stride + (tid & 7) * 8); }
__device__ __forceinline__ void st_k16(LAS unsigned char* kb, v4u v, int wave, int lane) { const int t = wave * 64 + lane, key = t >> 3, c = t & 7; *(LAS v4u*)(kb + c * 1024 + ((key ^ c) * 16)) = v; }
__device__ __forceinline__ void st_v16(LAS unsigned char* vb, v4u v, int tid) { const int key = tid >> 3, c = tid & 7; *(LAS v4u*)(vb + (c >> 2) * 4096 + (key >> 3) * 512 + (key & 7) * 64 + (c & 3) * 16) = v; }

__device__ __forceinline__ float half_max(float v) { const auto rr = __builtin_amdgcn_permlane32_swap(__builtin_bit_cast(unsigned, v), __builtin_bit_cast(unsigned, v), false, false); return fmaxf(__builtin_bit_cast(float, (unsigned)rr[0]), __builtin_bit_cast(float, (unsigned)rr[1])); }
__device__ __forceinline__ float half_sum(float v) { const auto rr = __builtin_amdgcn_permlane32_swap(__builtin_bit_cast(unsigned, v), __builtin_bit_cast(unsigned, v), false, false); return __builtin_bit_cast(float, (unsigned)rr[0]) + __builtin_bit_cast(float, (unsigned)rr[1]); }

typedef float f32x2_t __attribute__((ext_vector_type(2)));
__device__ __forceinline__ f32x2_t pk_sub(f32x2_t a, f32x2_t b) { f32x2_t r; asm("v_pk_add_f32 %0, %1, %2 neg_lo:[0,1] neg_hi:[0,1]" : "=v"(r) : "v"(a), "v"(b)); return r; }
__device__ __forceinline__ float max3f(float a, float b, float c) { float r; asm("v_max3_f32 %0, %1, %2, %3" : "=v"(r) : "v"(a), "v"(b), "v"(c)); return r; }
__device__ __forceinline__ void softmax_pv(f32x16_t& s0, f32x16_t& s1, float& m_run, float& l_run, f32x16_t (&o)[2], const LAS unsigned char* vb, int lane, float tbias = 0.f) {
    float tm = -INFINITY, tm2 = -INFINITY;
#pragma unroll
    for (int r = 0; r < 16; r += 2) { tm = max3f(tm, s0[r], s1[r]); tm2 = max3f(tm2, s0[r + 1], s1[r + 1]); }
    tm = half_max(max3f(tm, tm2, tm2)) + tbias;
    const float m_new = fmaxf(m_run, tm);
    const float m_use = (m_new == -INFINITY) ? 0.f : m_new;
    const float alpha = __builtin_amdgcn_exp2f(m_run - m_use);
    { const float ms = m_use - tbias; const f32x2_t mm = {ms, ms};
#pragma unroll
      for (int r = 0; r < 16; r += 2) { const f32x2_t d0 = pk_sub(f32x2_t{s0[r], s0[r + 1]}, mm), d1 = pk_sub(f32x2_t{s1[r], s1[r + 1]}, mm);
          s0[r] = __builtin_amdgcn_exp2f(d0[0]); s0[r + 1] = __builtin_amdgcn_exp2f(d0[1]); s1[r] = __builtin_amdgcn_exp2f(d1[0]); s1[r + 1] = __builtin_amdgcn_exp2f(d1[1]); } }
    float rs;
    { typedef float f32x8_t __attribute__((ext_vector_type(8)));
      const f32x16_t ps = s0 + s1;
      const f32x8_t a8 = __builtin_shufflevector(ps, ps, 0, 1, 2, 3, 4, 5, 6, 7) + __builtin_shufflevector(ps, ps, 8, 9, 10, 11, 12, 13, 14, 15);
      const f32x4_t a4 = __builtin_shufflevector(a8, a8, 0, 1, 2, 3) + __builtin_shufflevector(a8, a8, 4, 5, 6, 7);
      const f32x2_t a2 = __builtin_shufflevector(a4, a4, 0, 1) + __builtin_shufflevector(a4, a4, 2, 3);
      rs = a2[0] + a2[1]; }
    rs = half_sum(rs);
    l_run = l_run * alpha + rs; m_run = m_new;
    if (__any(alpha != 1.0f)) {
#pragma unroll
        for (int r = 0; r < 16; ++r) { o[0][r] *= alpha; o[1][r] *= alpha; } }
    pv_tile(o, vb, s0, s1, lane);
}

__device__ __forceinline__ void attn_prompt_unit(const Ptrs& P, LAS unsigned char* L, int b, int g, int qb, int tid_param, bool fill) {
    const int tid_in = tid_param;
    const int wave = __builtin_amdgcn_readfirstlane(tid_in >> 6), hh = wave >> 1, th = wave & 1, m0 = b * TP + 64 * qb, h = g * 4 + hh;
    bf16x8_t qf[4]; f32x16_t oacc[2], o[2], s0, s1;
    {
    int tid = tid_in; asm volatile("" : "+v"(tid));
    const int lane = tid & 63, r32 = lane & 31, hi = lane >> 5;
    const int tl = 32 * th + r32, t = 64 * qb + tl;
    LAS float* BT = (LAS float*)(L + A_BT); LAS unsigned* SEL = (LAS unsigned*)(L + A_SEL); LAS unsigned* UNI = (LAS unsigned*)(L + A_UNION); LAS float* IMP = (LAS float*)(L + A_IMP);
    const float NEG = -INFINITY;
    __syncthreads();
    if (fill) BT[tid] = P.rel_bias[BUCKET[tid & 127] * 16 + g * 4 + (tid >> 7)] * LOG2E;
    if (fill) { LAS float* RB = (LAS float*)(L + A_RB);
#pragma unroll 2
      for (int k = 0; k < 8; ++k) { const int e = tid + 512 * k, z = e & 255, a = (e >> 8) & 3, hd = e >> 10; const int d = 191 - (z + a);
          RB[e] = (d < 0) ? -INFINITY : P.rel_bias[BUCKET[d > 127 ? 127 : d] * 16 + g * 4 + hd] * LOG2E; } }
    if (tid == 0) UNI[0] = 0u;
#pragma unroll
    for (int d0 = 0; d0 < 4; ++d0) qf[d0] = *(const bf16x8_t*)(P.qb + (size_t)(m0 + tl) * 1024 + h * 64 + 16 * d0 + 8 * hi);
    const float g0 = P.ngs[(size_t)(m0 + tl) * 48 + h];
    {
        const bf16_t* ksrc = P.kcb + ((size_t)b * 64 * 4 + g) * 64; const bf16_t* vsrc = P.vcb + ((size_t)b * 64 * 4 + g) * 64;
        st_k16(L + A_K0, ld_k16(ksrc, 256, wave, lane), wave, lane); st_v16(L + A_V0, ld_v16(vsrc, 256, tid), tid);
        __syncthreads();
        qk_tile(s0, s1, L + A_K0, qf, r32, hi);
#pragma unroll
        for (int r = 0; r < 16; ++r) { const int i0 = crow(r, hi); const int d0 = t - 32 * i0 - 31, d1 = d0 - 1024;
            s0[r] = (d0 >= 0) ? s0[r] + BT[hh * 128 + (d0 > 127 ? 127 : d0)] : NEG;
            s1[r] = (d1 >= 0) ? s1[r] + BT[hh * 128 + (d1 > 127 ? 127 : d1)] : NEG; }
        float m_run = NEG, l_run = 0.f;
#pragma unroll
        for (int r = 0; r < 16; ++r) { o[0][r] = 0.f; o[1][r] = 0.f; }
        softmax_pv(s0, s1, m_run, l_run, o, L + A_V0, lane);
        const float inv = l_run > 0.f ? 1.0f / l_run : 0.f;
#pragma unroll
        for (int r = 0; r < 16; r += 2) { const int sb = crow(r, hi) >> 1;
            IMP[(hh * 64 + tl) * 32 + sb] = (s0[r] + s0[r + 1]) * inv; IMP[(hh * 64 + tl) * 32 + 16 + sb] = (s1[r] + s1[r + 1]) * inv; }
        const float sc = g0 * inv;
#pragma unroll
        for (int r = 0; r < 16; ++r) { oacc[0][r] = o[0][r] * sc; oacc[1][r] = o[1][r] * sc; }
    }
    __syncthreads();
    {
        const int tk = tid >> 3, sub = tid & 7; unsigned bits = 0u;
        if (qb + 1 <= 16) { bits = (sub == 0) ? ((1u << (qb + 1)) - 1u) : 0u; }
        else {
            float imp[32];
#pragma unroll
            for (int j = 0; j < 32; ++j) imp[j] = IMP[(0 * 64 + tk) * 32 + j] + IMP[(1 * 64 + tk) * 32 + j] + IMP[(2 * 64 + tk) * 32 + j] + IMP[(3 * 64 + tk) * 32 + j];
#pragma unroll
            for (int q4 = 0; q4 < 4; ++q4) {
                float mine = 0.f;
#pragma unroll
                for (int j = 0; j < 32; ++j) mine = (j == (sub * 4 + q4)) ? imp[j] : mine;
                const int sb = sub * 4 + q4;
                const bool forced = (sb == 0) || (sb == qb) || (sb == qb - 1); const bool cand = (sb >= 1) && (sb <= qb - 2);
                int rank = 0;
#pragma unroll
                for (int j = 1; j < 32; ++j) rank += (j <= qb - 2 && (imp[j] > mine || (imp[j] == mine && j < sb))) ? 1 : 0;
                if (forced || (cand && rank < 13)) bits |= 1u << sb;
            }
        }
        bits |= __shfl_xor(bits, 1); bits |= __shfl_xor(bits, 2); bits |= __shfl_xor(bits, 4);
        if (sub == 0) { SEL[tk] = bits; __hip_atomic_fetch_or(UNI, bits, __ATOMIC_RELAXED, __HIP_MEMORY_SCOPE_WORKGROUP); }
    }
    }
    __syncthreads();
    int tid = tid_in; asm volatile("" : "+v"(tid));
    const int lane = tid & 63, r32 = lane & 31, hi = lane >> 5, tl = 32 * th + r32;
    LAS float* BT = (LAS float*)(L + A_BT); LAS unsigned* SEL = (LAS unsigned*)(L + A_SEL); LAS unsigned* UNI = (LAS unsigned*)(L + A_UNION);
    const float NEG = -INFINITY;
    unsigned rem = UNI[0]; const unsigned selbits = SEL[tl];
    int wj = qb - (qb < 8 ? qb : 8);
    const bf16_t* ksel = P.kvb + ((size_t)0 * M + (size_t)b * TP) * 256 + g * 64; const bf16_t* vsel = P.kvb + ((size_t)1 * M + (size_t)b * TP) * 256 + g * 64;
    const bf16_t* kwin = P.kvb + ((size_t)2 * M + (size_t)b * TP) * 256 + g * 64; const bf16_t* vwin = P.kvb + ((size_t)3 * M + (size_t)b * TP) * 256 + g * 64;
    int ckind, cj, nkind, nj;
    { ckind = 0; cj = __builtin_ctz(rem); rem &= rem - 1u; }
    st_k16(L + A_K0, ld_k16(ksel + (size_t)cj * 64 * 256, 256, wave, lane), wave, lane); st_v16(L + A_V0, ld_v16(vsel + (size_t)cj * 64 * 256, 256, tid), tid);
#define PA_POP(K_, J_) { if (rem) { K_ = 0; J_ = __builtin_ctz(rem); rem &= rem - 1u; } else if (wj <= qb) { K_ = 1; J_ = wj; ++wj; } else { K_ = -1; J_ = 0; } }
#define PA_LOAD(KR_, VR_, K_, J_) { if ((K_) >= 0) { KR_ = ld_k16(((K_) ? kwin : ksel) + (size_t)(J_) * 64 * 256, 256, wave, lane); VR_ = ld_v16(((K_) ? vwin : vsel) + (size_t)(J_) * 64 * 256, 256, tid); } }
    int n2kind, n2j;
    PA_POP(nkind, nj)
    v4u kreg = {0u, 0u, 0u, 0u}, vreg = {0u, 0u, 0u, 0u};
    PA_LOAD(kreg, vreg, nkind, nj)
    __syncthreads();
    float m_run = NEG, l_run = 0.f;
#pragma unroll
    for (int r = 0; r < 16; ++r) { o[0][r] = 0.f; o[1][r] = 0.f; }
    int buf = 0;
    for (;;) {
        PA_POP(n2kind, n2j)
        v4u kreg2 = {0u, 0u, 0u, 0u}, vreg2 = {0u, 0u, 0u, 0u};
        PA_LOAD(kreg2, vreg2, n2kind, n2j)
        const LAS unsigned char* kb = L + (buf ? A_K1 : A_K0); const LAS unsigned char* vb = L + (buf ? A_V1 : A_V0);
        const int dj = qb - cj;
        const int dbase = 64 * dj + tl;
        qk_tile(s0, s1, kb, qf, r32, hi);
        const float tbias = (ckind == 0 && ((selbits >> cj) & 1u) == 0u) ? NEG : (dj <= 2 ? 0.f : BT[hh * 128 + 127]);
        if (dj <= 2) {
            const int y0 = 191 - dbase + 4 * hi, a = y0 & 3;
            const LAS f32x4_t* rb = (const LAS f32x4_t*)(L + A_RB) + (((hh * 4 + a) * 256 + (y0 - a)) >> 2);
#pragma unroll
            for (int gq = 0; gq < 4; ++gq) { const f32x4_t b0 = rb[2 * gq], b1 = rb[2 * gq + 8];
#pragma unroll
                for (int j = 0; j < 4; ++j) { s0[4 * gq + j] += b0[j]; s1[4 * gq + j] += b1[j]; } }
        } else {
            if (ckind == 1 && dj == 8) {
#pragma unroll
                for (int r = 0; r < 16; ++r) { const int k0 = crow(r, hi); const int d0 = dbase - k0, d1 = d0 - 32; if (d0 > 512) s0[r] = NEG; if (d1 > 512) s1[r] = NEG; }
            }
        }
        softmax_pv(s0, s1, m_run, l_run, o, vb, lane, tbias);
        if (nkind >= 0) { st_k16(L + (buf ? A_K0 : A_K1), kreg, wave, lane); st_v16(L + (buf ? A_V0 : A_V1), vreg, tid); }
        __syncthreads();
        if (ckind == 0 && nkind != 0) {
            const float sc = P.ngs[(size_t)(m0 + tl) * 48 + 16 + h] * (l_run > 0.f ? 1.0f / l_run : 0.f);
#pragma unroll
            for (int r = 0; r < 16; ++r) { oacc[0][r] += o[0][r] * sc; oacc[1][r] += o[1][r] * sc; o[0][r] = 0.f; o[1][r] = 0.f; }
            m_run = NEG; l_run = 0.f;
        }
        if (nkind < 0) break;
        ckind = nkind; cj = nj; nkind = n2kind; nj = n2j; kreg = kreg2; vreg = vreg2; buf ^= 1;
    }
#undef PA_POP
#undef PA_LOAD
    {
        const float sc = P.ngs[(size_t)(m0 + tl) * 48 + 32 + h] * (l_run > 0.f ? 1.0f / l_run : 0.f);
#pragma unroll
        for (int r = 0; r < 16; ++r) { oacc[0][r] += o[0][r] * sc; oacc[1][r] += o[1][r] * sc; }
    }
    bf16_t* orow = P.xcat + (size_t)(m0 + tl) * D + 1024 + h * 64;
#pragma unroll
    for (int dd = 0; dd < 2; ++dd)
#pragma unroll
        for (int gq = 0; gq < 4; ++gq) { uint2 w; w.x = cvtpk(oacc[dd][4 * gq], oacc[dd][4 * gq + 1]); w.y = cvtpk(oacc[dd][4 * gq + 2], oacc[dd][4 * gq + 3]);
            *(uint2*)(orow + 32 * dd + 8 * gq + 4 * hi) = w; }
}
__device__ __forceinline__ void attn_prompt_stage(const Ptrs& P, LAS unsigned char* L, int bid, int nblk, int tid) {
    for (int pi = bid; pi < 256; pi += nblk) {
        const int bg = pi >> 4, s = pi & 15;
        for (int u = 0; u < 2; ++u) attn_prompt_unit(P, L, bg >> 2, bg & 3, u ? 31 - s : s, tid, u == 0);
    }
}

constexpr int S_BT = 131072 + 1024, S_IMP = S_BT + 2048, S_PC = 131072 + 8192, S_Q = S_PC + 4096;
__device__ __forceinline__ v4u pack8(const float4 a, const float4 b) { v4u t; t.x = pk2(a.x, a.y); t.y = pk2(a.z, a.w); t.z = pk2(b.x, b.y); t.w = pk2(b.z, b.w); return t; }
struct Rows16 { float4 r[16]; };
__device__ __forceinline__ void rows_load(Rows16& T, const float* base, int stride, int nvalid, int lane) {
    const float* p = base + (size_t)(lane >> 4) * stride + 4 * (lane & 15); const size_t inc = (size_t)4 * stride; (void)nvalid;
#pragma unroll
    for (int i = 0; i < 16; ++i) { T.r[i] = *(const float4*)p; p += inc; }
}
__device__ __forceinline__ void rows_store(const Rows16& T, float* dst, bool first, int lane) {
    float* p = dst + (size_t)(lane >> 4) * 512 + 4 * (lane & 15);
    if (!first) *(float4*)p = T.r[0];
#pragma unroll
    for (int i = 1; i < 16; ++i) *(float4*)(p + (size_t)i * 2048) = T.r[i];
}
typedef unsigned v2u __attribute__((ext_vector_type(2)));
__device__ __forceinline__ v2u pack4(const float4 a) { v2u t; t.x = pk2(a.x, a.y); t.y = pk2(a.z, a.w); return t; }
__device__ __forceinline__ void rows_stage_k(LAS unsigned char* kb, const Rows16& T, int nvalid, int lane) {
    const int q = lane >> 4, dc = lane & 15, c = dc >> 1, p = dc & 1; const bool part = nvalid < 64;
    LAS unsigned char* be = kb + c * 1024 + ((q ^ c) * 16) + p * 8;
    LAS unsigned char* bo = kb + c * 1024 + (((q ^ c) ^ 4) * 16) + p * 8;
#pragma unroll
    for (int i = 0; i < 16; ++i) { float4 a = T.r[i]; if (i > 0 && part) a = make_float4(0.f, 0.f, 0.f, 0.f);
        *(LAS v2u*)(((i & 1) ? bo : be) + 128 * (i >> 1)) = pack4(a); }
}
__device__ __forceinline__ void rows_stage_v(LAS unsigned char* vb, const Rows16& T, int nvalid, int lane) {
    const int q = lane >> 4, dc = lane & 15; const bool part = nvalid < 64;
    LAS unsigned char* b0 = vb + (dc >> 3) * 4096 + q * 64 + (dc & 7) * 8;
#pragma unroll
    for (int i = 0; i < 16; ++i) { float4 a = T.r[i]; if (i > 0 && part) a = make_float4(0.f, 0.f, 0.f, 0.f);
        *(LAS v2u*)(b0 + (i >> 1) * 512 + (i & 1) * 256) = pack4(a); }
}
__device__ __forceinline__ void attn_sample_unit(const Ptrs& P, LAS unsigned char* L, int b, int g, int tid) {
    const int lane = tid & 63, wave = __builtin_amdgcn_readfirstlane(tid >> 6), r32 = lane & 31, hi = lane >> 5, q = r32 & 15, tok = q >> 2, hh = q & 3, h = g * 4 + hh;
    LAS float* BT = (LAS float*)(L + S_BT); LAS float* IMP = (LAS float*)(L + S_IMP + wave * 512);
    LAS unsigned char* KB = L + wave * 16384; LAS unsigned char* VB = KB + 8192;
    const float NEG = -INFINITY; const int mrow = MP + b * TS + tok;
    __syncthreads();
    BT[tid] = P.rel_bias[BUCKET[tid & 127] * 16 + g * 4 + (tid >> 7)] * LOG2E;
    bf16x8_t qf[4];
#pragma unroll
    for (int d0 = 0; d0 < 4; ++d0) qf[d0] = *(const bf16x8_t*)(P.qb + (size_t)mrow * 1024 + h * 64 + 16 * d0 + 8 * hi);
    { const bf16_t* ksrc = P.kcb + ((size_t)((BP + b) * 64 + lane) * 4 + g) * 64; const bf16_t* vsrc = P.vcb + ((size_t)((BP + b) * 64 + lane) * 4 + g) * 64;
#pragma unroll
      for (int c = 0; c < 8; ++c) { *(LAS v4u*)(KB + c * 1024 + ((lane ^ c) * 16)) = *(const v4u*)(ksrc + 8 * c);
          *(LAS v4u*)(VB + (c >> 2) * 4096 + (lane >> 3) * 512 + (lane & 7) * 64 + (c & 3) * 16) = *(const v4u*)(vsrc + 8 * c); } }
    if (wave == 0) {
#pragma unroll
        for (int d0 = 0; d0 < 4; ++d0) *(LAS bf16x8_t*)(L + S_Q + ((d0 * 2 + hi) * 32 + r32) * 16) = qf[d0]; }
    __syncthreads();
    f32x16_t s0, s1, o[2];
    float m_run = NEG, l_run = 0.f;
#pragma unroll
    for (int r = 0; r < 16; ++r) { o[0][r] = 0.f; o[1][r] = 0.f; }
    unsigned selbits = 0u, uni = 0u;
    if (wave < 6) {
    qk_tile(s0, s1, KB, qf, r32, hi);
#pragma unroll
    for (int r = 0; r < 16; ++r) { const int i0 = crow(r, hi); const int d0 = PAST + tok - 32 * i0 - 31, d1 = d0 - 1024;
        s0[r] += BT[hh * 128 + (d0 > 127 ? 127 : d0)]; s1[r] += BT[hh * 128 + (d1 > 127 ? 127 : d1)]; }
    softmax_pv(s0, s1, m_run, l_run, o, VB, lane);
    const float inv = 1.0f / l_run;
#pragma unroll
    for (int r = 0; r < 16; r += 2) { float a = (s0[r] + s0[r + 1]) * inv, c = (s1[r] + s1[r + 1]) * inv;
        a += __shfl_xor(a, 1); a += __shfl_xor(a, 2); c += __shfl_xor(c, 1); c += __shfl_xor(c, 2);
        if (hh == 0 && r32 < 16) { const int sb = crow(r, hi) >> 1; IMP[tok * 32 + sb] = a; IMP[tok * 32 + 16 + sb] = c; } }
    if (wave == 0 && r32 < 16) { LAS float* PC = (LAS float*)(L + S_PC) + q * 64;
#pragma unroll
        for (int dd = 0; dd < 2; ++dd)
#pragma unroll
            for (int r = 0; r < 16; ++r) PC[32 * dd + crow(r, hi)] = o[dd][r] * inv; }
    asm volatile("s_waitcnt lgkmcnt(0)" ::: "memory");
    { const int tk = lane >> 4, sp = lane & 15; unsigned bits = 0u;
      float imp[32];
#pragma unroll
      for (int q4 = 0; q4 < 8; ++q4) { const f32x4_t v = *(const LAS f32x4_t*)(IMP + tk * 32 + 4 * q4); imp[4 * q4] = v[0]; imp[4 * q4 + 1] = v[1]; imp[4 * q4 + 2] = v[2]; imp[4 * q4 + 3] = v[3]; }
#pragma unroll
      for (int i = 0; i < 2; ++i) { const int sb = 2 * sp + i; const float mine = IMP[tk * 32 + sb]; int rank = 0;
#pragma unroll
          for (int j = 1; j <= 30; ++j) { const float v = imp[j]; rank += (v > mine || (v == mine && j < sb)) ? 1 : 0; }
          const bool forced = (sb == 0) || (sb == 31); const bool cand = (sb >= 1) && (sb <= 30);
          if (forced || (cand && rank < 13)) bits |= 1u << sb; }
      bits |= __shfl_xor(bits, 1); bits |= __shfl_xor(bits, 2); bits |= __shfl_xor(bits, 4); bits |= __shfl_xor(bits, 8);
      selbits = __shfl(bits, tok * 16);
      uni = (unsigned)(__builtin_amdgcn_readlane((int)bits, 0) | __builtin_amdgcn_readlane((int)bits, 16) | __builtin_amdgcn_readlane((int)bits, 32) | __builtin_amdgcn_readlane((int)bits, 48)); }
    }
    m_run = NEG; l_run = 0.f;
#pragma unroll
    for (int r = 0; r < 16; ++r) { o[0][r] = 0.f; o[1][r] = 0.f; }
    const bool is_sel = wave < 6; const int first = is_sel ? wave : wave - 6, step = is_sel ? 6 : 2;
    unsigned long long rem = is_sel ? ((unsigned long long)uni | (1ull << 32)) : 0x1FFull;
    for (int k = 0; k < first; ++k) rem &= rem - 1ull;
#define TILE_POP(J_) { if (rem) { J_ = __builtin_ctzll(rem); for (int k_ = 0; k_ < step; ++k_) rem &= rem - 1ull; } else J_ = -1; }
#define SRC_TILE(jj, KB_, ST_, NV_) { const bool nk_ = is_sel ? ((jj) == 32) : ((jj) == 8); \
        if (nk_) { NV_ = TS; if (is_sel) { KB_ = P.out + O_KVS + (size_t)(b * TS) * 1024 + 512 + g * 64; ST_ = 1024; } else { KB_ = P.out + O_WINS + ((size_t)(b * 512 + 508) * 2) * 256 + g * 64; ST_ = 512; } } \
        else if (is_sel) { const int pos0 = 64 * (jj); const int page = P.pt[b * 16 + (pos0 >> 7)]; KB_ = P.cache + (((size_t)page * 128 + (pos0 & 127)) * 4 + 2) * 256 + g * 64; ST_ = 1024; NV_ = 64; } \
        else { KB_ = P.swin + ((size_t)(b * 512 + 64 * (jj)) * 2) * 256 + g * 64; ST_ = 512; NV_ = 64; } }
    Rows16 KR, VR;
    int j; TILE_POP(j);
    if (j >= 0) { const float* kb0; int st0, nv0; SRC_TILE(j, kb0, st0, nv0); rows_load(KR, kb0, st0, nv0, lane); }
    while (j >= 0) {
        int jnext; TILE_POP(jnext);
        const float* kbc; int stc, nvc; SRC_TILE(j, kbc, stc, nvc);
        rows_stage_k(KB, KR, nvc, lane);
        const bool wcopy = !is_sel && j < 8; float* wdst = P.out + O_WINS + ((size_t)(b * 512 + 64 * j) - 4) * 512 + g * 64;
        if (wcopy) rows_store(KR, wdst, j == 0, lane);
        rows_load(VR, kbc + 256, stc, nvc, lane);
        bf16x8_t qt[4];
#pragma unroll
        for (int d0 = 0; d0 < 4; ++d0) qt[d0] = *(const LAS bf16x8_t*)(L + S_Q + ((d0 * 2 + hi) * 32 + r32) * 16);
        asm volatile("s_waitcnt lgkmcnt(0)" ::: "memory");
        const int tb = is_sel ? (PAST - 64 * j) : (512 - 64 * j);
        const int dbase = tb + tok;
        qk_tile(s0, s1, KB, qt, r32, hi);
        const float tbias = (is_sel && j < 32 && ((selbits >> j) & 1u) == 0u) ? NEG : (tb <= 128 ? 0.f : BT[hh * 128 + 127]);
        if (tb <= 128) {
#pragma unroll
            for (int r = 0; r < 16; ++r) { const int k0 = crow(r, hi); const int d0 = dbase - k0, d1 = d0 - 32;
                const float b0 = BT[hh * 128 + (d0 > 127 ? 127 : (d0 < 0 ? 0 : d0))], b1 = BT[hh * 128 + (d1 > 127 ? 127 : (d1 < 0 ? 0 : d1))];
                s0[r] = (d0 >= 0) ? s0[r] + b0 : NEG; s1[r] = (d1 >= 0) ? s1[r] + b1 : NEG; }
        } else {
            if (!is_sel && tb == 512) {
#pragma unroll
                for (int r = 0; r < 16; ++r) { const int k0 = crow(r, hi); const int d0 = dbase - k0, d1 = d0 - 32; if (d0 > 512) s0[r] = NEG; if (d1 > 512) s1[r] = NEG; }
            }
        }
        rows_stage_v(VB, VR, nvc, lane);
        if (wcopy) rows_store(VR, wdst + 256, j == 0, lane);
        asm volatile("" ::: "memory");
        { const int jn = (jnext >= 0) ? jnext : j; const float* kbn; int stn, nvn; SRC_TILE(jn, kbn, stn, nvn); rows_load(KR, kbn, stn, nvn, lane); }
        asm volatile("s_waitcnt lgkmcnt(0)" ::: "memory");
        softmax_pv(s0, s1, m_run, l_run, o, VB, lane, tbias);
        asm volatile("s_waitcnt lgkmcnt(0)" ::: "memory");
        j = jnext;
    }
#undef SRC_TILE
#undef TILE_POP
    int l2; asm volatile("v_mbcnt_lo_u32_b32 %0, -1, 0\n\tv_mbcnt_hi_u32_b32 %0, -1, %0" : "=v"(l2));
    if ((l2 & 31) < 16) {
        const int q2 = l2 & 15, hi2 = l2 >> 5;
        LAS float* PO = (LAS float*)KB + q2 * 64;
#pragma unroll
        for (int dd = 0; dd < 2; ++dd)
#pragma unroll
            for (int r = 0; r < 16; ++r) PO[32 * dd + crow(r, hi2)] = o[dd][r];
        if (hi2 == 0) { LAS float* PM = (LAS float*)(KB + 4096); PM[2 * q2] = m_run; PM[2 * q2 + 1] = l_run; }
    }
    __syncthreads();
    {
        const int tid2 = wave * 64 + l2;
        const int cq = tid2 >> 5, cd = 2 * (tid2 & 31), ct = cq >> 2, ch = g * 4 + (cq & 3);
        float msel = NEG, mwin = NEG;
#pragma unroll
        for (int w = 0; w < 8; ++w) { const float mw = ((LAS float*)(L + w * 16384 + 4096))[2 * cq]; if (w < 6) msel = fmaxf(msel, mw); else mwin = fmaxf(mwin, mw); }
        float lsel = 0.f, lwin = 0.f, os0 = 0.f, os1 = 0.f, ow0 = 0.f, ow1 = 0.f;
#pragma unroll
        for (int w = 0; w < 8; ++w) { const LAS float* PM = (LAS float*)(L + w * 16384 + 4096); const LAS float* PO = (LAS float*)(L + w * 16384) + cq * 64 + cd;
            const float mw = PM[2 * cq], lw = PM[2 * cq + 1]; const float f = __builtin_amdgcn_exp2f(mw - (w < 6 ? msel : mwin));
            if (w < 6) { lsel += lw * f; os0 += PO[0] * f; os1 += PO[1] * f; } else { lwin += lw * f; ow0 += PO[0] * f; ow1 += PO[1] * f; } }
        const LAS float* PC = (LAS float*)(L + S_PC) + cq * 64 + cd;
        const size_t mr = (size_t)(MP + b * TS + ct);
        const float g0 = P.ngs[mr * 48 + ch], g1 = P.ngs[mr * 48 + 16 + ch], g2 = P.ngs[mr * 48 + 32 + ch];
        const float is = g1 / lsel, iw = g2 / lwin;
        const float r0 = g0 * PC[0] + os0 * is + ow0 * iw, r1 = g0 * PC[1] + os1 * is + ow1 * iw;
        *(unsigned*)(P.xcat + mr * D + 1024 + ch * 64 + cd) = pk2(r0, r1);
    }
}
__device__ __forceinline__ void attn_sample_stage(const Ptrs& P, LAS unsigned char* L, int bid, int nblk, int tid) {
    for (int u = bid; u < BS * 4; u += nblk) attn_sample_unit(P, L, u >> 2, u & 3, tid);
}

__device__ __forceinline__ float fsig(float x) { return __builtin_amdgcn_rcpf(1.0f + __builtin_amdgcn_exp2f(-x * 1.4426950408889634f)); }
__device__ __forceinline__ float bflo(unsigned u) { return __builtin_bit_cast(float, u << 16); }
__device__ __forceinline__ float bfhi(unsigned u) { return __builtin_bit_cast(float, u & 0xffff0000u); }
struct EpiIn {
    static constexpr bool PERM = true, AFTER_DRAIN = false, HAS_MID = false;
    float* out; float* poolin; bf16_t* qb; bf16_t* kvb; bf16_t* gateb;
    __device__ __forceinline__ void operator()(const pg8::f32x4 (&acc)[2][2][4][2], const pg8::Unit& u, int wr, int wc, int fr, int fq) const {
        const int pn = u.pn, pm = u.pm;
#pragma unroll
        for (int ai = 0; ai < 2; ++ai)
#pragma unroll
            for (int m = 0; m < 4; ++m) {
                const int row = pm * 256 + ai * 128 + wr * 64 + m * 16 + fr;
#pragma unroll
                for (int bj = 0; bj < 2; ++bj) {
                    const int cc = bj * 128 + wc * 32 + 8 * fq; const pg8::f32x4 v0 = acc[ai][bj][m][0], v1 = acc[ai][bj][m][1];
                    if (pn < 4) { float* p = poolin + (size_t)row * PW + pn * 256 + cc; *(pg8::f32x4*)p = v0; *(pg8::f32x4*)(p + 4) = v1; }
                    else if (pn < 8) { v4u w; w.x = pk2(v0[0] * QSCALE, v0[1] * QSCALE); w.y = pk2(v0[2] * QSCALE, v0[3] * QSCALE); w.z = pk2(v1[0] * QSCALE, v1[1] * QSCALE); w.w = pk2(v1[2] * QSCALE, v1[3] * QSCALE);
                        *(v4u*)(qb + (size_t)row * 1024 + (pn - 4) * 256 + cc) = w; }
                    else if (pn < 14) { const int slot = pn - 8; float* dst = nullptr;
                        if (slot < 4) dst = (pm < 32) ? out + O_KVP + (size_t)row * 1024 + slot * 256 + cc : out + O_KVS + (size_t)(row - MP) * 1024 + slot * 256 + cc;
                        else if (pm >= 32) { const int r = row - MP; dst = out + O_WINS + ((size_t)((r >> 2) * 512 + 508 + (r & 3)) * 2 + (slot - 4)) * 256 + cc; }
                        else if ((pm & 7) >= 6) dst = out + O_WINP + ((size_t)((row >> 11) * 512 + (row & 2047) - 1536) * 2 + (slot - 4)) * 256 + cc;
                        if (dst) { *(pg8::f32x4*)dst = v0; *(pg8::f32x4*)(dst + 4) = v1; }
                        if (slot >= 2) { v4u w; w.x = pk2(v0[0], v0[1]); w.y = pk2(v0[2], v0[3]); w.z = pk2(v1[0], v1[1]); w.w = pk2(v1[2], v1[3]); *(v4u*)(kvb + ((size_t)(slot - 2) * M + row) * 256 + cc) = w; } }
                    else { v4u w; w.x = pk2(fsig(v0[0]), fsig(v0[1])); w.y = pk2(fsig(v0[2]), fsig(v0[3])); w.z = pk2(fsig(v1[0]), fsig(v1[1])); w.w = pk2(fsig(v1[2]), fsig(v1[3]));
                        *(v4u*)(gateb + (size_t)row * 4096 + (pn - 14) * 256 + cc) = w; }
                }
            }
    }
};
struct EpiB16 {
    static constexpr bool PERM = true, AFTER_DRAIN = false, HAS_MID = false;
    bf16_t* C; int ldc;
    __device__ __forceinline__ void operator()(const pg8::f32x4 (&acc)[2][2][4][2], const pg8::Unit& u, int wr, int wc, int fr, int fq) const {
#pragma unroll
        for (int ai = 0; ai < 2; ++ai)
#pragma unroll
            for (int m = 0; m < 4; ++m) { const int row = u.pm * 256 + ai * 128 + wr * 64 + m * 16 + fr;
#pragma unroll
                for (int bj = 0; bj < 2; ++bj) { const int col = u.pn * 256 + bj * 128 + wc * 32 + 8 * fq; const pg8::f32x4 v0 = acc[ai][bj][m][0], v1 = acc[ai][bj][m][1];
                    v4u w; w.x = pk2(v0[0], v0[1]); w.y = pk2(v0[2], v0[3]); w.z = pk2(v1[0], v1[1]); w.w = pk2(v1[2], v1[3]); *(v4u*)(C + (size_t)row * ldc + col) = w; } }
    }
};
struct EpiMerge {
    static constexpr bool PERM = true, AFTER_DRAIN = false, HAS_MID = true;
    const bf16_t* gateb; bf16_t* mergedb;
    __device__ __forceinline__ void mid(pg8::f32x4 (&acc)[2][2][4][2], const pg8::Unit& u, int wr, int wc, int fr, int fq) const {
        const bf16_t* gp = gateb + (size_t)(u.pm * 256) * 4096 + u.pn * 256; asm volatile("" : "+s"(gp));
        unsigned lo = (unsigned)((wr * 64 + fr) * 4096 + wc * 32 + 8 * fq); asm volatile("" : "+v"(lo));
#pragma unroll
        for (int ai = 0; ai < 2; ++ai)
#pragma unroll
            for (int m = 0; m < 4; ++m) {
#pragma unroll
                for (int bj = 0; bj < 2; ++bj) { const unsigned off = lo + (unsigned)((ai * 128 + m * 16) * 4096 + bj * 128);
                    const v4u ga = *(const v4u*)(gp + off), gb = *(const v4u*)(gp + off + 2048);
                    const unsigned gaw[4] = {ga.x, ga.y, ga.z, ga.w}, gbw[4] = {gb.x, gb.y, gb.z, gb.w};
#pragma unroll
                    for (int k = 0; k < 4; ++k) { const float r0 = bflo(gaw[k]) * __builtin_amdgcn_rcpf(fmaxf(bflo(gbw[k]), 1e-30f)), r1 = bfhi(gaw[k]) * __builtin_amdgcn_rcpf(fmaxf(bfhi(gbw[k]), 1e-30f));
                        acc[ai][bj][m][k >> 1][(k & 1) * 2] *= r0; acc[ai][bj][m][k >> 1][(k & 1) * 2 + 1] *= r1; } }
                asm volatile("" : "+v"(acc[ai][0][m][0]), "+v"(acc[ai][0][m][1]), "+v"(acc[ai][1][m][0]), "+v"(acc[ai][1][m][1]) :: "memory"); }
    }
    __device__ __forceinline__ void operator()(const pg8::f32x4 (&acc)[2][2][4][2], const pg8::Unit& u, int wr, int wc, int fr, int fq) const {
#pragma unroll
        for (int ai = 0; ai < 2; ++ai)
#pragma unroll
            for (int m = 0; m < 4; ++m) { const int row = u.pm * 256 + ai * 128 + wr * 64 + m * 16 + fr;
#pragma unroll
                for (int bj = 0; bj < 2; ++bj) { const int col = u.pn * 256 + bj * 128 + wc * 32 + 8 * fq;
                    const v4u gb = *(const v4u*)(gateb + (size_t)row * 4096 + 2048 + col); const unsigned gbw[4] = {gb.x, gb.y, gb.z, gb.w}; unsigned w[4];
#pragma unroll
                    for (int k = 0; k < 4; ++k) w[k] = pk2(acc[ai][bj][m][k >> 1][(k & 1) * 2] * fmaxf(bflo(gbw[k]), 1e-30f), acc[ai][bj][m][k >> 1][(k & 1) * 2 + 1] * fmaxf(bfhi(gbw[k]), 1e-30f));
                    v4u o; o.x = w[0]; o.y = w[1]; o.z = w[2]; o.w = w[3]; *(v4u*)(mergedb + (size_t)row * D + col) = o; }
                asm volatile("" ::: "memory"); }
    }
};
#define DPP_F(oldv, src, ctrl) __builtin_bit_cast(float, __builtin_amdgcn_update_dpp(__builtin_bit_cast(int, (float)(oldv)), __builtin_bit_cast(int, (float)(src)), (ctrl), 0xf, 0xf, false))
struct EpiUpAct {
    static constexpr bool PERM = true, AFTER_DRAIN = false, HAS_MID = false;
    bf16_t* actb; float* out; float* ws; const float* conv_w; const float* conv_b;
    __device__ __forceinline__ void operator()(const pg8::f32x4 (&acc)[2][2][4][2], const pg8::Unit& u, int wr, int wc, int fr, int fq) const {
        const int pn = u.pn, pm = u.pm; const bool smp = pm >= 32;
        const int f = pn * 128 + wc * 32 + 8 * fq;
        float cw0[8], cw1[8], cw2[8], cb[8];
        { const F8 a = ld8f(conv_w + f), b = ld8f(conv_w + FF + f), c = ld8f(conv_w + 2 * FF + f), d = ld8f(conv_b + f);
#pragma unroll
          for (int e = 0; e < 8; ++e) { cw0[e] = a.v[e]; cw1[e] = b.v[e]; cw2[e] = c.v[e]; cb[e] = d.v[e]; } }
#pragma unroll
        for (int ai = 0; ai < 2; ++ai)
#pragma unroll
            for (int m = 0; m < 4; ++m) {
                const int row = pm * 256 + ai * 128 + wr * 64 + m * 16 + fr;
                float o[8], gq[8], vq[8];
#pragma unroll
                for (int e = 0; e < 8; ++e) {
                    const float g = acc[ai][1][m][e >> 2][e & 3], gp = (m > 0) ? acc[ai][1][m > 0 ? m - 1 : 0][e >> 2][e & 3] : g, v = acc[ai][0][m][e >> 2][e & 3];
                    const float p1 = DPP_F(DPP_F(0.f, gp, 0x121), g, 0x111);
                    const float p2 = DPP_F(DPP_F(0.f, gp, 0x122), g, 0x112);
                    o[e] = gelu_tanh(cb[e] + cw0[e] * p2 + cw1[e] * p1 + cw2[e] * g) * v; gq[e] = g; vq[e] = v; }
                { v4u w; w.x = pk2(o[0], o[1]); w.y = pk2(o[2], o[3]); w.z = pk2(o[4], o[5]); w.w = pk2(o[6], o[7]); *(v4u*)(actb + (size_t)row * FF + f) = w; }
                if (smp) { const int r = row - MP, t = r & 3;
                    if (t < 2) { const size_t fid = 256 + (size_t)(r >> 2) * 2 + t; F8 a, b;
#pragma unroll
                        for (int e = 0; e < 8; ++e) { a.v[e] = vq[e]; b.v[e] = gq[e]; }
                        st8f(ws + W_FIXV + fid * FF + f, a); st8f(ws + W_FIXG + fid * FF + f, b); }
                    else { F8 b;
#pragma unroll
                        for (int e = 0; e < 8; ++e) b.v[e] = gq[e];
                        st8f(out + O_CONVS + ((size_t)(r >> 2) * 2 + (t - 2)) * FF + f, b); } }
                else {
                    if (m == 0 && fr < 2) { const size_t fid = (size_t)(row >> 6) * 2 + fr; F8 a, b;
#pragma unroll
                        for (int e = 0; e < 8; ++e) { a.v[e] = vq[e]; b.v[e] = gq[e]; }
                        st8f(ws + W_FIXV + fid * FF + f, a); st8f(ws + W_FIXG + fid * FF + f, b); }
                    if (m == 3 && fr >= 14) { F8 b;
#pragma unroll
                        for (int e = 0; e < 8; ++e) b.v[e] = gq[e];
                        st8f(ws + W_TAILG + ((size_t)(row >> 6) * 2 + (fr - 14)) * FF + f, b);
                        if ((row & 2047) >= 2046) st8f(out + O_CONVP + ((size_t)(row >> 11) * 2 + ((row & 2047) - 2046)) * FF + f, b); } }
            }
    }
};
__device__ __forceinline__ void act_fix_stage(const Ptrs& P, size_t gtid, size_t nthr) {
    const float* FV = P.ws + W_FIXV; const float* FG = P.ws + W_FIXG; const float* TG = P.ws + W_TAILG;
    for (size_t i = gtid; i < (size_t)512 * (FF / 8); i += nthr) { const int fid = (int)(i / (FF / 8)), f = (int)(i % (FF / 8)) * 8;
        F8 g1, g2; int row;
#pragma unroll
        for (int e = 0; e < 8; ++e) { g1.v[e] = 0.f; g2.v[e] = 0.f; }
        if (fid < 256) { const int blk = fid >> 1, ii = fid & 1; row = blk * 64 + ii; const int t = row & 2047;
            if (ii == 0) { if (t != 0) { g1 = ld8f(TG + ((size_t)(blk - 1) * 2 + 1) * FF + f); g2 = ld8f(TG + ((size_t)(blk - 1) * 2 + 0) * FF + f); } }
            else { g1 = ld8f(FG + (size_t)(fid - 1) * FF + f); if (t != 1) g2 = ld8f(TG + ((size_t)(blk - 1) * 2 + 1) * FF + f); } }
        else { const int sidx = fid - 256, b = sidx >> 1, t = sidx & 1; row = MP + b * TS + t;
            if (t == 0) { g1 = ld8f(P.sconv + ((size_t)b * 2 + 1) * FF + f); g2 = ld8f(P.sconv + ((size_t)b * 2 + 0) * FF + f); }
            else { g1 = ld8f(FG + (size_t)(fid - 1) * FF + f); g2 = ld8f(P.sconv + ((size_t)b * 2 + 1) * FF + f); } }
        const F8 g0 = ld8f(FG + (size_t)fid * FF + f), vv = ld8f(FV + (size_t)fid * FF + f), c0 = ld8f(P.conv_w + f), c1 = ld8f(P.conv_w + FF + f), c2 = ld8f(P.conv_w + 2 * FF + f), cb = ld8f(P.conv_b + f);
        F8 o;
#pragma unroll
        for (int e = 0; e < 8; ++e) o.v[e] = gelu_tanh(cb.v[e] + c0.v[e] * g2.v[e] + c1.v[e] * g1.v[e] + c2.v[e] * g0.v[e]) * vv.v[e];
        st8h(P.actb + (size_t)row * FF + f, o); }
}
__device__ __forceinline__ void merge_sample_stage(const Ptrs& P, size_t gtid, size_t nthr) {
    const bf16_t* SL = (const bf16_t*)(P.ws + W_SLABM);
    for (size_t i = gtid; i < (size_t)MS * D / 8; i += nthr) { const int r = (int)(i >> 8), c = (int)(i & 255) * 8;
        F8 a, b;
#pragma unroll
        for (int e = 0; e < 8; ++e) { a.v[e] = 0.f; b.v[e] = 0.f; }
#pragma unroll
        for (int k = 0; k < 4; ++k) { const F8 x = ld8h(SL + (size_t)k * MS * D + (size_t)r * D + c), y = ld8h(SL + (size_t)(k + 4) * MS * D + (size_t)r * D + c);
#pragma unroll
            for (int e = 0; e < 8; ++e) { a.v[e] += x.v[e]; b.v[e] += y.v[e]; } }
        const F8 ga = ld8h(P.gateb + (size_t)(MP + r) * 4096 + c), gb = ld8h(P.gateb + (size_t)(MP + r) * 4096 + 2048 + c);
        F8 o;
#pragma unroll
        for (int e = 0; e < 8; ++e) o.v[e] = ga.v[e] * a.v[e] + gb.v[e] * b.v[e];
        st8h(P.mergedb + (size_t)(MP + r) * D + c, o); }
}
__device__ __forceinline__ float4 pool_prev(const Ptrs& P, const float* PI, int m, int t, int j, bool isP, int b, int c) {
    const int tt = t - j;
    if (tt >= 0) return *(const float4*)(PI + (size_t)(m - j) * PW + c);
    if (!isP) return *(const float4*)(P.spool + ((size_t)b * 15 + 15 + tt) * 1024 + c);
    return make_float4(0.f, 0.f, 0.f, 0.f);
}
__device__ __forceinline__ void pool_stage(const Ptrs& P, size_t gtid, size_t nthr) {
    const float* PI = P.ws + W_POOLIN;
    const int nseg = (int)(nthr >> 8), seg = (int)(gtid >> 8), c = (int)(gtid & 255) * 4, w = 2 << (c >> 8);
    if (nseg > 0 && seg < nseg) {
        const int rps = (M + nseg - 1) / nseg, mb = seg * rps, me = (mb + rps < M) ? mb + rps : M;
        float4 S = make_float4(0.f, 0.f, 0.f, 0.f);
        int m = mb;
        while (m < me) {
            const bool isP = m < MP; const int b = isP ? m / TP : (m - MP) / TS, t = isP ? m % TP : (m - MP) % TS;
            if (m != mb && isP && t >= w && t + 7 < TP && m + 7 < me) {
                float4 x[8], v[8];
#pragma unroll
                for (int i = 0; i < 8; ++i) { x[i] = *(const float4*)(PI + (size_t)(m + i) * PW + c); v[i] = *(const float4*)(PI + (size_t)(m + i - w) * PW + c); }
                const float ic = 1.0f / (float)w;
#pragma unroll
                for (int i = 0; i < 8; ++i) { S.x += x[i].x - v[i].x; S.y += x[i].y - v[i].y; S.z += x[i].z - v[i].z; S.w += x[i].w - v[i].w;
                    uint2 o; o.x = pk2(S.x * ic - x[i].x, S.y * ic - x[i].y); o.y = pk2(S.z * ic - x[i].z, S.w * ic - x[i].w); *(uint2*)(P.xcat + (size_t)(m + i) * D + c) = o; }
                m += 8;
            } else {
                const float4 x = *(const float4*)(PI + (size_t)m * PW + c);
                if (m == mb || t == 0) { S = x;
#pragma unroll
                    for (int jj = 1; jj < 16; ++jj) { const int tt = t - jj; const bool inw = jj < w; const bool fromPI = inw && tt >= 0, fromS = inw && tt < 0 && !isP;
                        const float* p = fromPI ? PI + (size_t)(m - jj) * PW + c : (fromS ? P.spool + ((size_t)b * 15 + 15 + tt) * 1024 + c : PI + (size_t)m * PW + c);
                        const float4 vv = *(const float4*)p; const float sc = (fromPI || fromS) ? 1.0f : 0.0f;
                        S.x += vv.x * sc; S.y += vv.y * sc; S.z += vv.z * sc; S.w += vv.w * sc; } }
                else { const float4 v = pool_prev(P, PI, m, t, w, isP, b, c); S.x += x.x - v.x; S.y += x.y - v.y; S.z += x.z - v.z; S.w += x.w - v.w; }
                const int pos = isP ? t : PAST + t; const float ic = 1.0f / (float)((w < pos + 1) ? w : pos + 1);
                uint2 o; o.x = pk2(S.x * ic - x.x, S.y * ic - x.y); o.y = pk2(S.z * ic - x.z, S.w * ic - x.w); *(uint2*)(P.xcat + (size_t)m * D + c) = o;
                ++m;
            }
        }
    }
    for (size_t i = gtid; i < (size_t)BP * 15 * 256; i += nthr) { const int c = (int)(i & 255) * 4; const int r = (int)(i >> 8); const int b = r / 15, j = r % 15;
        *(float4*)(P.out + O_POOLP + (size_t)r * 1024 + c) = *(const float4*)(PI + (size_t)(b * TP + (TP - 15) + j) * PW + c); }
    for (size_t i = gtid; i < (size_t)BS * 4 * 256; i += nthr) { const int c = (int)(i & 255) * 4; const int r = (int)(i >> 8); const int b = r >> 2, j = r & 3;
        *(float4*)(P.out + O_POOLS + ((size_t)b * 15 + 11 + j) * 1024 + c) = *(const float4*)(PI + (size_t)(MP + b * TS + j) * PW + c); }
}
__device__ __forceinline__ void prologue_state_copies(const Ptrs& P, size_t gtid, size_t nthr) {
    for (size_t i = gtid; i < (size_t)BS * 11 * 256; i += nthr) { const int c = (int)(i & 255) * 4; const int r = (int)(i >> 8); const int b = r / 11, j = r % 11;
        *(float4*)(P.out + O_POOLS + ((size_t)b * 15 + j) * 1024 + c) = *(const float4*)(P.spool + ((size_t)b * 15 + j + 4) * 1024 + c); }
}
#define XB_TMO      128
#define XB_XCNT(j)  (256  + 64 * (j))
#define XB_XSUB(j)  (1280 + 64 * (j))
#define XB_XGEN(j)  (2304 + 64 * (j))
#define XB_TOP      3328
#define XB_TOPGEN   3392
#define XCD_BAR_WORDS 3456
#define XB_SPIN_CAP (1u << 22)

__device__ __forceinline__ unsigned xb_ld(unsigned* p)              { return __hip_atomic_load(p, __ATOMIC_RELAXED, __HIP_MEMORY_SCOPE_AGENT); }
__device__ __forceinline__ unsigned xb_add(unsigned* p, unsigned v) { return __hip_atomic_fetch_add(p, v, __ATOMIC_RELAXED, __HIP_MEMORY_SCOPE_AGENT); }
__device__ __forceinline__ unsigned xb_xcc_id() { return (unsigned)__builtin_amdgcn_s_getreg((3 << 11) | 20) & 0xFu; }
#define XB_SPIN(cond, bar) do { unsigned _sp = 0; while (cond) { __builtin_amdgcn_s_sleep(1); \
    if ((++_sp & 255u) == 0u) { if (xb_ld(&(bar)[XB_TMO])) break; if (_sp > XB_SPIN_CAP) { atomicAdd(&(bar)[XB_TMO], 1u); break; } } } } while (0)

struct XcdBarrier {
    unsigned* bar; unsigned x;
    volatile LAS unsigned* st;
    int wv;
};

__device__ __forceinline__ XcdBarrier xcd_barrier_post(unsigned* bar, volatile LAS unsigned* st) {
    XcdBarrier b; b.bar = bar; b.x = xb_xcc_id(); b.st = st;
    if (threadIdx.x == 0) (void)xb_add(&bar[XB_XCNT(b.x)], 1u);
    return b;
}
__device__ __forceinline__ void xcd_barrier_complete(unsigned* bar, unsigned x, unsigned& nloc, unsigned& nx) {
    const unsigned G = gridDim.x * gridDim.y * gridDim.z;
    unsigned sum, cnt, mine, sp = 0u;
    for (;;) {
        sum = 0u; cnt = 0u; mine = 0u;
#pragma unroll
        for (unsigned j = 0; j < 16; ++j) { const unsigned c = xb_ld(&bar[XB_XCNT(j)]); sum += c; cnt += (c > 0u) ? 1u : 0u; mine = (j == x) ? c : mine; }
        if (sum == G) break;
        __builtin_amdgcn_s_sleep(1);
        if ((++sp & 255u) == 0u) { if (xb_ld(&bar[XB_TMO])) break; if (sp > XB_SPIN_CAP) { atomicAdd(&bar[XB_TMO], 1u); break; } }
    }
    nloc = mine > 0u ? mine : 1u; nx = cnt > 0u ? cnt : 1u;
}

__device__ __forceinline__ void xcd_barrier(const XcdBarrier& b) {
    asm volatile("s_waitcnt vmcnt(0)" ::: "memory");
    __syncthreads();
    int xb_lane; asm volatile("v_mbcnt_lo_u32_b32 %0, -1, 0\n\tv_mbcnt_hi_u32_b32 %0, -1, %0" : "=v"(xb_lane));
    if (b.wv == 0 && xb_lane == 0) {
        unsigned* bar = b.bar;
        __builtin_amdgcn_s_waitcnt(0);
        unsigned nloc = b.st[0], nx = b.st[1];
        if (nloc == 0u) { xcd_barrier_complete(bar, b.x, nloc, nx); b.st[0] = nloc; b.st[1] = nx; }
        const unsigned old = xb_add(&bar[XB_XSUB(b.x)], 1u);
        const unsigned gen = old / nloc;
        if (old + 1u == (gen + 1u) * nloc) {
            __builtin_amdgcn_fence(__ATOMIC_RELEASE, "agent");
            asm volatile("s_waitcnt vmcnt(0)" ::: "memory");
            const unsigned og = xb_add(&bar[XB_TOP], 1u);
            const unsigned tg = og / nx;
            if (og + 1u == (tg + 1u) * nx) xb_add(&bar[XB_TOPGEN], 1u);
            else XB_SPIN(xb_ld(&bar[XB_TOPGEN]) == tg, bar);
            __builtin_amdgcn_fence(__ATOMIC_ACQUIRE, "agent");
            xb_add(&bar[XB_XGEN(b.x)], 1u);
            asm volatile("s_waitcnt vmcnt(0)" ::: "memory");
        } else {
            XB_SPIN(xb_ld(&bar[XB_XGEN(b.x)]) == gen, bar);
            __builtin_amdgcn_fence(__ATOMIC_ACQUIRE, "agent");
            asm volatile("s_waitcnt vmcnt(0)" ::: "memory");
        }
    }
    __syncthreads();
}


constexpr int LDS_BYTES = 147456;
constexpr int MISC_OFF = 131072 + 320;

struct Args { Ptrs P; unsigned* bar; };
static_assert(sizeof(Ptrs) % 8 == 0, "Ptrs is copied as 64-bit words");

__global__ void __launch_bounds__(512, 2) mega(Args a) {
    extern __shared__ __attribute__((aligned(16))) unsigned char lds[];
    volatile LAS unsigned* MISC = (volatile LAS unsigned*)((LAS unsigned char*)lds + MISC_OFF);
    if (threadIdx.x < 32) MISC[threadIdx.x] = 0u;
    __syncthreads();
    const int wave_s = __builtin_amdgcn_readfirstlane(threadIdx.x >> 6);
    XcdBarrier bar = xcd_barrier_post(a.bar, MISC + 8); bar.wv = wave_s;
    const int bid = blockIdx.x, nblk = gridDim.x;
    float* fl = (float*)lds;
    PG8_LAS unsigned char* glds = (PG8_LAS unsigned char*)lds;
#if defined(__HIP_DEVICE_COMPILE__)
#define PFRESH() const __attribute__((address_space(4))) unsigned long long* kp_ = (const __attribute__((address_space(4))) unsigned long long*)__builtin_amdgcn_kernarg_segment_ptr(); asm volatile("" : "+s"(kp_)); \
                 union { Ptrs P; unsigned long long w[sizeof(Ptrs) / 8]; } pu_; _Pragma("unroll") for (int i_ = 0; i_ < (int)(sizeof(Ptrs) / 8); ++i_) pu_.w[i_] = kp_[i_]; \
                 const Ptrs& P = pu_.P; float* ws = P.ws; (void)ws;
#else
#define PFRESH() const Ptrs& P = a.P; float* ws = P.ws; (void)ws;
#endif
#define FRESH() int lane; asm volatile("v_mbcnt_lo_u32_b32 %0, -1, 0\n\tv_mbcnt_hi_u32_b32 %0, -1, %0" : "=v"(lane)); const int wave = wave_s, tid = wave_s * 64 + lane, gwave = bid * 8 + wave, nwaves = nblk * 8; \
                const size_t gtid = (size_t)bid * 512 + tid, nthr = (size_t)nblk * 512; (void)tid; (void)wave; (void)gwave; (void)nwaves; (void)gtid; (void)nthr; PFRESH();

    const bool defer = (nblk == 256);
#pragma nounroll
    for (int step = 0; step < 3; ++step) {
        const int what = ((bid >> 3) & 1) ? (step == 0 ? 1 : step == 1 ? 0 : 2) : (step == 0 ? 0 : step == 1 ? 2 : 1);
        if (what == 0) { FRESH(); prologue_transposes(P, lds, 0, defer ? TR_P0 : TR_ALL, gwave, nwaves, wave, lane); }
        else if (what == 1) { FRESH(); prologue_wprime(P, fl, bid, nblk, tid); }
        else { FRESH(); prologue_ng(P, gtid, nthr); prologue_cmp(P, gtid, nthr, gwave, nwaves, lane); prologue_state_copies(P, gtid, nthr); rms_stage<0>(P, gwave, nwaves, lane); }
        __syncthreads();
    }
    xcd_barrier(bar);
#pragma nounroll
    for (int step = 0; step < 2; ++step) {
        if (((step ^ bid) & 1) == 0) {
            PFRESH(); pg8::Gemm g{P.ub, P.wt_in, M, NIN, D, D, D}; pg8::StaticOrder S; S.init(M, NIN, nblk, bid); EpiIn E{P.out, ws + W_POOLIN, P.qb, P.kvb, P.gateb};
            pg8::gemm_phase<EpiIn, pg8::StaticOrder, true, true>(glds, g, S, E, wave_s);
        } else {
            { FRESH(); ng_stage(P, bid, nblk, wave, lane); }
            { FRESH(); compress_sample_lds(P, glds, bid, nblk, wave, lane, tid); }
        }
        __syncthreads();
    }
    xcd_barrier(bar);
    if (nblk > 64 && bid >= 32) { FRESH(); pool_stage(P, gtid - (size_t)32 * 512, nthr - (size_t)32 * 512); }
    else if (nblk > 64) { FRESH(); compress_prompt_split(P, glds, bid, wave, lane); }
    else { FRESH(); pool_stage(P, gtid, nthr); compress_mfma<1, true>(P, gwave, nwaves, lane); }
    xcd_barrier(bar);
    if ((bid >> 3) & 1) { { FRESH(); attn_sample_stage(P, glds, bid, nblk, tid); } { FRESH(); attn_prompt_stage(P, glds, bid, nblk, tid); } }
    else { { FRESH(); attn_prompt_stage(P, glds, bid, nblk, tid); } { FRESH(); attn_sample_stage(P, glds, bid, nblk, tid); } }
    xcd_barrier(bar);
    { PFRESH(); pg8::Gemm g{P.xcat, P.wt_pn, MP, D, D, D, D}; pg8::StaticOrder S; S.init(MP, D, nblk, bid); EpiMerge E{P.gateb, P.mergedb};
      pg8::gemm_phase<EpiMerge, pg8::StaticOrder, true, true>(glds, g, S, E, wave_s); }
    { PFRESH(); pg8::Gemm g{P.xcat, P.wt_pn, M, D, 256, D, D}; pg8::SplitOrder S{nblk, bid, 8, 256, MP / 256, D / 256}; pg8::EpiSlab E{(bf16_t*)(ws + W_SLABM), D, 256, MP / 256, (size_t)MS * D};
      pg8::gemm_phase<pg8::EpiSlab, pg8::SplitOrder, true, true>(glds, g, S, E, wave_s); }
    if (defer && bid >= 128) { FRESH(); prologue_transposes(P, lds, TR_P0, TR_SLOTA, (bid - 128) * 8 + wave, 1024, wave, lane); }
    xcd_barrier(bar);
    { FRESH(); merge_sample_stage(P, gtid, nthr); }
    xcd_barrier(bar);
    { PFRESH(); pg8::Gemm g{P.mergedb, P.wt_out, MP, D, D, D, D}; pg8::StaticOrder S; S.init(MP, D, nblk, bid); EpiB16 E{P.tb, D};
      pg8::gemm_phase<EpiB16, pg8::StaticOrder, true, true>(glds, g, S, E, wave_s); }
    { PFRESH(); pg8::Gemm g{P.mergedb, P.wt_out, M, D, 256, D, D}; pg8::SplitOrder S{nblk, bid, 8, 256, MP / 256, D / 256}; pg8::EpiSlab E{(bf16_t*)(ws + W_SLAB), D, 256, MP / 256, (size_t)MS * D};
      pg8::gemm_phase<pg8::EpiSlab, pg8::SplitOrder, true, true>(glds, g, S, E, wave_s); }
    if (defer && bid >= 128) { FRESH(); prologue_transposes(P, lds, TR_SLOTA, TR_UP, (bid - 128) * 8 + wave, 1024, wave, lane); }
    xcd_barrier(bar);
    { FRESH(); rms_stage<1>(P, gwave, nwaves, lane); }
    xcd_barrier(bar);
    { PFRESH(); pg8::Gemm g{P.u2b, P.wt_up, M, 2 * FF, D, D, D}; pg8::StaticOrder S; S.init(M, 2 * FF, nblk, bid); EpiUpAct E{P.actb, P.out, ws, P.conv_w, P.conv_b};
      pg8::gemm_phase<EpiUpAct, pg8::StaticOrder, false, true>(glds, g, S, E, wave_s); }
    if (defer && bid >= 216) { FRESH(); prologue_transposes(P, lds, TR_UP, TR_ALL, (bid - 216) * 8 + wave, 320, wave, lane); }
    xcd_barrier(bar);
    { FRESH(); act_fix_stage(P, gtid, nthr); }
    xcd_barrier(bar);
    { PFRESH(); pg8::Gemm g{P.actb, P.wt_down, MP, D, FF, FF, FF}; pg8::StaticOrder S; S.init(MP, D, nblk, bid); EpiB16 E{P.tb, D};
      pg8::gemm_phase<EpiB16, pg8::StaticOrder, true, true>(glds, g, S, E, wave_s); }
    { PFRESH(); pg8::Gemm g{P.actb, P.wt_down, M, D, 512, FF, FF}; pg8::SplitOrder S{nblk, bid, 11, 512, MP / 256, D / 256}; pg8::EpiSlab E{(bf16_t*)(ws + W_SLAB), D, 512, MP / 256, (size_t)MS * D};
      pg8::gemm_phase<pg8::EpiSlab, pg8::SplitOrder, true, true>(glds, g, S, E, wave_s); }
    xcd_barrier(bar);
    { FRESH(); rms_stage<2>(P, gwave, nwaves, lane); }
#undef FRESH
#undef PFRESH
}
}

extern "C" void kernel_launch(void* const* d_in, const int* in_sizes, int n_in, void* d_out, int out_size, void* d_ws, size_t ws_size, hipStream_t stream) {
    if (n_in != 28 || (size_t)out_size != O_END || ws_size < WS_TOTAL) return;
    static int grid = 0;
    if (grid == 0) {
        int dev = 0, cus = 0, per_cu = 0;
        if (hipGetDevice(&dev) != hipSuccess || hipDeviceGetAttribute(&cus, hipDeviceAttributeMultiprocessorCount, dev) != hipSuccess) { grid = -1; return; }
        if (hipFuncSetAttribute((const void*)mega, hipFuncAttributeMaxDynamicSharedMemorySize, LDS_BYTES) != hipSuccess) { grid = -1; return; }
        if (hipOccupancyMaxActiveBlocksPerMultiprocessor(&per_cu, (const void*)mega, 512, LDS_BYTES) != hipSuccess || per_cu < 1) { (void)hipGetLastError(); per_cu = 1; }
        grid = cus;
    }
    if (grid < 0) return;
    (void)hipMemsetAsync(d_ws, 0, WS_CTL_BYTES, stream);
    Args a{};
    Ptrs& P = a.P;
    P.xp = (const float*)d_in[0]; P.xs = (const float*)d_in[1]; P.cache = (const float*)d_in[2]; P.pt = (const int*)d_in[3]; P.swin = (const float*)d_in[4];
    P.spool = (const float*)d_in[5]; P.sconv = (const float*)d_in[6]; P.g_pre = (const float*)d_in[7]; P.w_in = (const float*)d_in[8];
    P.pe_k = (const float*)d_in[9]; P.w1_k = (const float*)d_in[10]; P.w2_k = (const float*)d_in[11]; P.pe_v = (const float*)d_in[12]; P.w1_v = (const float*)d_in[13]; P.w2_v = (const float*)d_in[14];
    P.rel_bias = (const float*)d_in[15]; P.w_pgrp = (const float*)d_in[16]; P.pool_scale = (const float*)d_in[17]; P.w_pproj = (const float*)d_in[18]; P.w_nproj = (const float*)d_in[19];
    P.w_out = (const float*)d_in[20]; P.g_pmix = (const float*)d_in[21]; P.g_pffn = (const float*)d_in[22]; P.w_up = (const float*)d_in[23]; P.conv_w = (const float*)d_in[24];
    P.conv_b = (const float*)d_in[25]; P.w_down = (const float*)d_in[26]; P.g_postffn = (const float*)d_in[27];
    P.out = (float*)d_out; P.ws = (float*)((char*)d_ws + WS_F32_OFF);
    bf16_t* hb = (bf16_t*)((char*)d_ws + WS_H_OFF);
    P.ub = hb + H_UB; P.xcat = hb + H_XCAT; P.mergedb = hb + H_MERGEDB; P.u2b = hb + H_U2B; P.upb = hb + H_UPB; P.actb = hb + H_ACTB; P.gateb = hb + H_GATEB;
    P.wt_in = hb + H_WTIN; P.wt_ng = hb + H_WTNG; P.wt_pn = hb + H_WTPN; P.wt_out = hb + H_WTOUT; P.wt_up = hb + H_WTUP; P.wt_down = hb + H_WTDOWN;
    P.qb = hb + H_QB; P.kvb = hb + H_KVB; P.kcb = hb + H_KCB; P.vcb = hb + H_VCB; P.w1f = hb + H_W1F; P.w2f = hb + H_W2F; P.tb = hb + H_TB; P.ngs = P.ws + W_NGS; P.c1 = P.ws + W_C1;
    a.bar = (unsigned*)d_ws + 4096;
    hipLaunchKernelGGL(mega, dim3(grid), dim3(512), LDS_BYTES, stream, a);
}
```

```cpp
#include <hip/hip_runtime.h>
#include <stdint.h>
#include <math.h>

namespace pg8 {
#define PG8_LAS __attribute__((address_space(3)))
typedef unsigned short bf16_t;
typedef short bf16x8 __attribute__((ext_vector_type(8)));
typedef float f32x4 __attribute__((ext_vector_type(4)));
typedef unsigned u32x4 __attribute__((ext_vector_type(4)));
constexpr int BM = 256, BK = 64, HALF = 128, HTB = HALF * BK * 2  , STAGE_BYTES = 8 * HTB, NXCD = 8, WGM = 8;

__host__ __device__ __forceinline__ int lds_byte(int r, int c) { const int st = (r >> 4) * 2 + (c >> 5), rr = r & 15, cc = c & 31, ob = rr * 64 + cc * 2; return st * 1024 + (ob ^ (((ob >> 9) & 1) << 5)); }
__host__ __device__ __forceinline__ void stage_rc(int b, int& R, int& C) { const int st = b / 1024, sb = b % 1024, swz = sb ^ (((sb >> 9) & 1) << 5); R = (st >> 1) * 16 + swz / 64; C = (st & 1) * 32 + (swz % 64) / 2; }
__host__ __device__ __forceinline__ int perm32(int rho) { const int n = rho >> 4, i = rho & 15; return 8 * (i >> 2) + 4 * n + (i & 3); }

struct Unit { int pm, pn, koff; };
struct Gemm { const bf16_t* A; const bf16_t* Bt; int M, N, K, lda, ldb; };
struct StaticOrder {
    int nM, nN, nwg, G, c;
    __host__ __device__ void init(int M, int N, int G_, int c_) { nM = M / BM; nN = N / BM; nwg = nM * nN; G = G_; c = c_; }
    __host__ __device__ bool next(int i, Unit& u) const {
        const long L = (long)i * G + c; if (L >= nwg) return false;
        int wgid = (int)L; { const int q = nwg / NXCD, r = nwg % NXCD, xcd = wgid % NXCD, off = wgid / NXCD; wgid = (xcd < r ? xcd * (q + 1) : r * (q + 1) + (xcd - r) * q) + off; }
        const int nig = WGM * nN, gid = wgid / nig, fm = gid * WGM, gsz = (nM - fm) < WGM ? (nM - fm) : WGM;
        u.pm = fm + ((wgid % nig) % gsz); u.pn = (wgid % nig) / gsz; u.koff = 0; return true;
    }
    __device__ __forceinline__ void a_ready(const Unit&) const {}
    __device__ __forceinline__ void done(const Unit&) const {}
};
__device__ __forceinline__ unsigned cvt_pk_bf16(float lo, float hi) { unsigned r; asm volatile("v_cvt_pk_bf16_f32 %0, %1, %2" : "=v"(r) : "v"(lo), "v"(hi)); return r; }
struct EpiF32X {
    static constexpr bool PERM = false, AFTER_DRAIN = false, HAS_MID = false;
    float* C; int ldc; int split_pn; int split_add;
    __device__ __forceinline__ void operator()(const f32x4 (&acc)[2][2][4][2], const Unit& u, int wr, int wc, int fr, int fq) const {
        const int row0 = u.pm * BM + wr * 64 + fr, col0 = u.pn * BM + (u.pn >= split_pn ? split_add : 0) + wc * 32 + 4 * fq;
#pragma unroll
        for (int ai = 0; ai < 2; ++ai)
#pragma unroll
            for (int m = 0; m < 4; ++m) { float* rowp = C + (size_t)(row0 + ai * HALF + m * 16) * ldc + col0;
#pragma unroll
                for (int bj = 0; bj < 2; ++bj)
#pragma unroll
                    for (int n = 0; n < 2; ++n) *(f32x4*)(rowp + bj * HALF + n * 16) = acc[ai][bj][m][n]; }
    }
};
struct SplitOrder {
    int G, c, S, Ks, pm0, nN;
    __device__ __forceinline__ bool next(int i, Unit& u) const { const int L = i * G + c; if (L >= 2 * nN * S) return false; const int ks = L % S, t = L / S; u.pm = pm0 + (t & 1); u.pn = t >> 1; u.koff = ks * Ks; return true; }
    __device__ __forceinline__ void a_ready(const Unit&) const {}
    __device__ __forceinline__ void done(const Unit&) const {}
};
typedef unsigned u32x2 __attribute__((ext_vector_type(2)));
struct EpiSlab {
    static constexpr bool PERM = false, AFTER_DRAIN = false, HAS_MID = false;
    unsigned short* C; int ldc; int Ks; int pm0; size_t slab;
    __device__ __forceinline__ void operator()(const f32x4 (&acc)[2][2][4][2], const Unit& u, int wr, int wc, int fr, int fq) const {
        const int row0 = (u.pm - pm0) * BM + wr * 64 + fr, col0 = u.pn * BM + wc * 32 + 4 * fq; unsigned short* base = C + (size_t)(u.koff / Ks) * slab;
#pragma unroll
        for (int ai = 0; ai < 2; ++ai)
#pragma unroll
            for (int m = 0; m < 4; ++m) { unsigned short* rowp = base + (size_t)(row0 + ai * HALF + m * 16) * ldc + col0;
#pragma unroll
                for (int bj = 0; bj < 2; ++bj)
#pragma unroll
                    for (int n = 0; n < 2; ++n) { u32x2 w; w.x = cvt_pk_bf16(acc[ai][bj][m][n][0], acc[ai][bj][m][n][1]); w.y = cvt_pk_bf16(acc[ai][bj][m][n][2], acc[ai][bj][m][n][3]);
                        *(u32x2*)(rowp + bj * HALF + n * 16) = w; } }
    }
};
template <class Epi, class Sched, bool ALIGN_EPI = false, bool SP2 = false>
__device__ __forceinline__ void gemm_phase(PG8_LAS unsigned char* lds, const Gemm g, const Sched& S, const Epi& E, const int wid) {
    int lane; asm volatile("v_mbcnt_lo_u32_b32 %0, -1, 0\n\tv_mbcnt_hi_u32_b32 %0, -1, %0" : "=v"(lane));
    const int wu = __builtin_amdgcn_readfirstlane(wid);
    const int tid = wu * 64 + lane, wr = wu >> 2, wc = wu & 3, fr = lane & 15, fq = lane >> 4;
    const int K = g.K, nt = K / BK;
    unsigned voffA[2], voffB[2];
#pragma unroll
    for (int i = 0; i < 2; ++i) { int R, C; stage_rc(tid * 16 + i * 8192, R, C); const int Rb = Epi::PERM ? ((R & ~31) + perm32(R & 31)) : R;
        voffA[i] = (unsigned)(R * g.lda + C) * 2u; voffB[i] = (unsigned)(Rb * g.ldb + C) * 2u; }
    const size_t kstep = (size_t)(BK * 2);
    const size_t hstepA = (size_t)HALF * g.lda * 2, hstepB = (size_t)HALF * g.ldb * 2;
    const size_t tstepA = 2 * hstepA, tstepB = 2 * hstepB;
    const unsigned ldsw = (unsigned)wu * 1024u;
    const int aoff = lds_byte(wr * 64 + fr, fq * 8), boff = lds_byte(wc * 32 + fr, fq * 8);
#define PG8_SA(b, h) (((b) * 2 + (h)) * HTB)
#define PG8_SB(b, h) ((4 + (b) * 2 + (h)) * HTB)
#define PG8_STAGE(bufoff, gbase, voff) do { _Pragma("unroll") for (int _i = 0; _i < 2; ++_i) \
        __builtin_amdgcn_global_load_lds((const unsigned*)((const char*)(gbase) + (voff)[_i]), (PG8_LAS unsigned*)(lds + (bufoff) + ldsw + _i * 8192), 16, 0, 0); } while (0)
#define PG8_LDA(dst, b, h) do { _Pragma("unroll") for (int m = 0; m < 4; ++m) _Pragma("unroll") for (int k = 0; k < 2; ++k) dst[m][k] = *(const PG8_LAS bf16x8*)(lds + PG8_SA(b, h) + aoff + m * 2048 + k * 1024); } while (0)
#define PG8_LDB(dst, b, h) do { _Pragma("unroll") for (int n = 0; n < 2; ++n) _Pragma("unroll") for (int k = 0; k < 2; ++k) dst[n][k] = *(const PG8_LAS bf16x8*)(lds + PG8_SB(b, h) + boff + n * 2048 + k * 1024); } while (0)
#define PG8_MMA(ai, bj, At, Bt) do { __builtin_amdgcn_s_setprio(1); _Pragma("unroll") for (int m = 0; m < 4; ++m) _Pragma("unroll") for (int n = 0; n < 2; ++n) _Pragma("unroll") for (int k = 0; k < 2; ++k) \
        acc[ai][bj][m][n] = __builtin_amdgcn_mfma_f32_16x16x32_bf16(Bt[n][k], At[m][k], acc[ai][bj][m][n], 0, 0, 0); __builtin_amdgcn_s_setprio(0); } while (0)
#define PG8_WAIT_V(n) asm volatile("s_waitcnt vmcnt(" #n ")" ::: "memory")
#define PG8_WAIT_L(n) asm volatile("s_waitcnt lgkmcnt(" #n ")" ::: "memory")
#define PG8_BAR __builtin_amdgcn_s_barrier()
#define PG8_SCHED __builtin_amdgcn_sched_barrier(0)
    Unit cur, nxt; int ui = 0;
    if (!S.next(0, cur)) return;
    f32x4 acc[2][2][4][2];
#pragma unroll
    for (int a = 0; a < 2; ++a)
#pragma unroll
        for (int b = 0; b < 2; ++b)
#pragma unroll
            for (int m = 0; m < 4; ++m)
#pragma unroll
                for (int n = 0; n < 2; ++n) acc[a][b][m][n] = (f32x4){0.f, 0.f, 0.f, 0.f};
    bf16x8 At[4][2], B0[2][2], B1[2][2];
    const char* cA = (const char*)g.A + (size_t)cur.pm * tstepA + (size_t)cur.koff * 2; const char* cB = (const char*)g.Bt + (size_t)cur.pn * tstepB + (size_t)cur.koff * 2;
    S.a_ready(cur);
    if constexpr (SP2) {
        PG8_STAGE(PG8_SB(0, 0), cB, voffB); PG8_STAGE(PG8_SB(0, 1), cB + hstepB, voffB); PG8_STAGE(PG8_SA(0, 0), cA, voffA); PG8_STAGE(PG8_SA(0, 1), cA + hstepA, voffA);
        if (wr == 1) PG8_BAR;
        PG8_WAIT_V(2); PG8_BAR;
        PG8_STAGE(PG8_SB(1, 0), cB + kstep, voffB); PG8_STAGE(PG8_SA(1, 0), cA + kstep, voffA); PG8_STAGE(PG8_SB(1, 1), cB + hstepB + kstep, voffB);
        PG8_WAIT_V(6); PG8_BAR;
    } else {
        PG8_STAGE(PG8_SB(0, 0), cB, voffB); PG8_STAGE(PG8_SA(0, 0), cA, voffA); PG8_STAGE(PG8_SB(0, 1), cB + hstepB, voffB); PG8_STAGE(PG8_SA(0, 1), cA + hstepA, voffA);
        if (wr == 1) PG8_BAR;
        PG8_WAIT_V(4); PG8_BAR;
        PG8_STAGE(PG8_SB(1, 0), cB + kstep, voffB); PG8_STAGE(PG8_SA(1, 0), cA + kstep, voffA); PG8_STAGE(PG8_SB(1, 1), cB + hstepB + kstep, voffB);
        PG8_WAIT_V(6); PG8_BAR;
    }
    for (;;) {
        const bool has_next = S.next(ui + 1, nxt);
        const char* nA = has_next ? (const char*)g.A + (size_t)nxt.pm * tstepA + (size_t)nxt.koff * 2 : cA; const char* nB = has_next ? (const char*)g.Bt + (size_t)nxt.pn * tstepB + (size_t)nxt.koff * 2 : cB;
        for (int t = 0; t < nt; t += 2) {
            const bool last = (t == nt - 2);
            const char* a1 = cA + (size_t)(t + 1) * kstep;
            const char* a2 = last ? nA : cA + (size_t)(t + 2) * kstep; const char* b2 = last ? nB : cB + (size_t)(t + 2) * kstep;
            const char* a3 = a2 + kstep; const char* b3 = b2 + kstep;
            if (last && has_next) S.a_ready(nxt);
            if constexpr (Epi::HAS_MID) { if (t == (nt >> 1)) E.mid(acc, cur, wr, wc, fr, fq); }
            if constexpr (SP2) {
            PG8_LDB(B0, 0, 0); PG8_LDB(B1, 0, 1); PG8_SCHED; PG8_LDA(At, 0, 0); PG8_STAGE(PG8_SA(1, 1), a1 + hstepA, voffA);
            PG8_WAIT_V(8); PG8_WAIT_L(0); PG8_BAR; PG8_MMA(0, 0, At, B0); PG8_MMA(0, 1, At, B1); PG8_BAR; PG8_SCHED;
            PG8_LDA(At, 0, 1); PG8_STAGE(PG8_SB(0, 0), b2, voffB); PG8_STAGE(PG8_SB(0, 1), b2 + hstepB, voffB); PG8_STAGE(PG8_SA(0, 0), a2, voffA);
            PG8_WAIT_V(8); PG8_WAIT_L(0); PG8_BAR; PG8_MMA(1, 0, At, B0); PG8_MMA(1, 1, At, B1); PG8_BAR; PG8_SCHED;
            PG8_LDB(B0, 1, 0); PG8_LDB(B1, 1, 1); PG8_SCHED; PG8_LDA(At, 1, 0); PG8_STAGE(PG8_SA(0, 1), a2 + hstepA, voffA);
            PG8_WAIT_V(8); PG8_WAIT_L(0); PG8_BAR; PG8_MMA(0, 0, At, B0); PG8_MMA(0, 1, At, B1); PG8_BAR; PG8_SCHED;
            PG8_LDA(At, 1, 1); PG8_STAGE(PG8_SB(1, 0), b3, voffB); PG8_STAGE(PG8_SB(1, 1), b3 + hstepB, voffB); PG8_STAGE(PG8_SA(1, 0), a3, voffA);
            PG8_WAIT_V(8); PG8_WAIT_L(0); PG8_BAR; PG8_MMA(1, 0, At, B0); PG8_MMA(1, 1, At, B1); PG8_BAR; PG8_SCHED;
            } else {
            PG8_LDB(B0, 0, 0); PG8_SCHED; PG8_LDA(At, 0, 0); PG8_STAGE(PG8_SA(1, 1), a1 + hstepA, voffA);
            PG8_WAIT_L(8); PG8_BAR; PG8_WAIT_L(0); PG8_MMA(0, 0, At, B0); PG8_BAR; PG8_SCHED;
            PG8_LDB(B1, 0, 1); PG8_STAGE(PG8_SB(0, 0), b2, voffB);
            PG8_BAR; PG8_WAIT_L(0); PG8_MMA(0, 1, At, B1); PG8_BAR;
            PG8_LDA(At, 0, 1); PG8_STAGE(PG8_SA(0, 0), a2, voffA);
            PG8_BAR; PG8_WAIT_L(0); PG8_MMA(1, 0, At, B0); PG8_BAR; PG8_SCHED;
            PG8_STAGE(PG8_SB(0, 1), b2 + hstepB, voffB);
            PG8_WAIT_V(6); PG8_BAR; PG8_MMA(1, 1, At, B1); PG8_BAR;
            PG8_LDB(B0, 1, 0); PG8_SCHED; PG8_LDA(At, 1, 0); PG8_STAGE(PG8_SA(0, 1), a2 + hstepA, voffA);
            PG8_WAIT_L(8); PG8_BAR; PG8_WAIT_L(0); PG8_MMA(0, 0, At, B0); PG8_BAR; PG8_SCHED;
            PG8_LDB(B1, 1, 1); PG8_STAGE(PG8_SB(1, 0), b3, voffB);
            PG8_BAR; PG8_WAIT_L(0); PG8_MMA(0, 1, At, B1); PG8_BAR;
            PG8_LDA(At, 1, 1); PG8_STAGE(PG8_SA(1, 0), a3, voffA);
            PG8_BAR; PG8_WAIT_L(0); PG8_MMA(1, 0, At, B0); PG8_BAR; PG8_SCHED;
            PG8_STAGE(PG8_SB(1, 1), b3 + hstepB, voffB);
            PG8_WAIT_V(6); PG8_BAR; PG8_MMA(1, 1, At, B1); PG8_BAR;
            }
        }
        if constexpr (ALIGN_EPI) { if (wr == 0) PG8_BAR; }
        if constexpr (!Epi::AFTER_DRAIN) { E(acc, cur, wr, wc, fr, fq); S.done(cur); }
        if (!has_next) break;
#pragma unroll
        for (int a = 0; a < 2; ++a)
#pragma unroll
            for (int b = 0; b < 2; ++b)
#pragma unroll
                for (int m = 0; m < 4; ++m)
#pragma unroll
                    for (int n = 0; n < 2; ++n) acc[a][b][m][n] = (f32x4){0.f, 0.f, 0.f, 0.f};
        cur = nxt; cA = nA; cB = nB; ++ui;
        if constexpr (ALIGN_EPI) { if (wr == 1) PG8_BAR; }
    }
    PG8_WAIT_V(0);
    if constexpr (!ALIGN_EPI) { if (wr == 0) PG8_BAR; }
    PG8_BAR;
    if constexpr (Epi::AFTER_DRAIN) { E.fused(acc, cur, wr, wc, fr, fq, lds, wid, lane); S.done(cur); }
#undef PG8_SA
#undef PG8_SB
#undef PG8_STAGE
#undef PG8_LDA
#undef PG8_LDB
#undef PG8_MMA
#undef PG8_WAIT_V
#undef PG8_WAIT_L
#undef PG8_BAR
#undef PG8_SCHED
}
}

namespace {
typedef unsigned short bf16_t;
#define LAS __attribute__((address_space(3)))
constexpr int D = 2048, BP = 4, TP = 2048, BS = 128, TS = 4, PAST = 2048;
constexpr int MP = BP * TP, MS = BS * TS, M = MP + MS;
constexpr int PW = 1024;
constexpr int INW = 7728, ZQ = 1024, ZKV = 2048, ZNG = 3584, ZMG = 3632;
constexpr int NIN = 7680;
constexpr int FF = 5632;
constexpr int NB = BP + BS;
constexpr float EPS = 1e-6f;

constexpr size_t O_YP = 0;
constexpr size_t O_YS = O_YP + (size_t)MP * D;
constexpr size_t O_KVP = O_YS + (size_t)MS * D;
constexpr size_t O_KVS = O_KVP + (size_t)MP * 1024;
constexpr size_t O_WINP = O_KVS + (size_t)MS * 1024;
constexpr size_t O_WINS = O_WINP + (size_t)BP * 512 * 512;
constexpr size_t O_POOLP = O_WINS + (size_t)BS * 512 * 512;
constexpr size_t O_POOLS = O_POOLP + (size_t)BP * 15 * 1024;
constexpr size_t O_CONVP = O_POOLS + (size_t)BS * 15 * 1024;
constexpr size_t O_CONVS = O_CONVP + (size_t)BP * 2 * FF;
constexpr size_t O_END = O_CONVS + (size_t)BS * 2 * FF;

constexpr size_t W_POOLIN = 0;
constexpr size_t W_H1 = W_POOLIN + (size_t)M * PW;
constexpr size_t W_NGS = W_H1 + (size_t)M * D;
constexpr size_t W_C1 = W_NGS + (size_t)M * 48;
constexpr size_t W_FIXV = W_C1 + 128;
constexpr size_t W_FIXG = W_FIXV + (size_t)512 * FF;
constexpr size_t W_TAILG = W_FIXG + (size_t)512 * FF;
constexpr size_t W_SLAB = W_TAILG + (size_t)256 * FF;
constexpr size_t W_SLABM = W_SLAB + (size_t)11 * MS * D;
constexpr size_t W_END = W_SLABM + (size_t)8 * MS * D;
constexpr size_t H_UB = 0;
constexpr size_t H_XCAT = H_UB + (size_t)M * D;
constexpr size_t H_MERGEDB = H_XCAT + (size_t)M * D;
constexpr size_t H_U2B = H_MERGEDB + (size_t)M * D;
constexpr size_t H_UPB = H_U2B + (size_t)M * D;
constexpr size_t H_ACTB = H_UPB + (size_t)M * 2 * FF;
constexpr size_t H_GATEB = H_ACTB + (size_t)M * FF;
constexpr size_t H_WTIN = H_GATEB + (size_t)M * 4096;
constexpr size_t H_WTNG = H_WTIN + (size_t)NIN * D;
constexpr size_t H_WTPN = H_WTNG + (size_t)64 * D;
constexpr size_t H_WTOUT = H_WTPN + (size_t)D * D;
constexpr size_t H_WTUP = H_WTOUT + (size_t)D * D;
constexpr size_t H_WTDOWN = H_WTUP + (size_t)2 * FF * D;
constexpr size_t H_QB = H_WTDOWN + (size_t)D * FF;
constexpr size_t H_KVB = H_QB + (size_t)M * 1024;
constexpr size_t H_KCB = H_KVB + (size_t)4 * M * 256;
constexpr size_t H_VCB = H_KCB + (size_t)NB * 64 * 256;
constexpr size_t H_W1F = H_VCB + (size_t)NB * 64 * 256;
constexpr size_t H_W2F = H_W1F + (size_t)2 * 64 * 4 * 512;
constexpr size_t H_TB = H_W2F + (size_t)2 * 2 * 4 * 512;
constexpr size_t H_END = H_TB + (size_t)MP * D;
constexpr size_t WS_CTL_BYTES = 1u << 20;
constexpr size_t WS_F32_OFF = WS_CTL_BYTES;
constexpr size_t WS_H_OFF = WS_F32_OFF + ((W_END * 4 + 255) / 256) * 256;
constexpr size_t WS_TOTAL = WS_H_OFF + H_END * 2;

__device__ const unsigned char BUCKET[128] = {0, 1, 2, 3, 4, 5, 6, 7, 8, 9, 10, 11, 12, 13, 14, 15, 16, 16, 16, 17, 17, 18, 18, 18, 19, 19, 19, 20, 20, 20, 20, 21, 21, 21, 21, 22, 22, 22, 22, 22, 23, 23, 23, 23, 23, 23, 24, 24, 24, 24, 24, 24, 25, 25, 25, 25, 25, 25, 25, 26, 26, 26, 26, 26, 26, 26, 26, 27, 27, 27, 27, 27, 27, 27, 27, 27, 27, 28, 28, 28, 28, 28, 28, 28, 28, 28, 28, 29, 29, 29, 29, 29, 29, 29, 29, 29, 29, 29, 29, 30, 30, 30, 30, 30, 30, 30, 30, 30, 30, 30, 30, 30, 30, 31, 31, 31, 31, 31, 31, 31, 31, 31, 31, 31, 31, 31, 31, 31};

struct Ptrs {
    const float *xp, *xs, *cache; const int* pt; const float *swin, *spool, *sconv, *g_pre, *w_in, *pe_k, *w1_k, *w2_k, *pe_v, *w1_v, *w2_v, *rel_bias, *w_pgrp, *pool_scale,
        *w_pproj, *w_nproj, *w_out, *g_pmix, *g_pffn, *w_up, *conv_w, *conv_b, *w_down, *g_postffn;
    float* out; float* ws;
    bf16_t *ub, *xcat, *mergedb, *u2b, *upb, *actb, *gateb, *wt_in, *wt_ng, *wt_pn, *wt_out, *wt_up, *wt_down, *qb, *kvb, *kcb, *vcb, *w1f, *w2f, *tb; float *ngs, *c1;
};

__device__ __forceinline__ unsigned f2bf(float f) { unsigned u = __builtin_bit_cast(unsigned, f); return (u + 0x7fffu + ((u >> 16) & 1u)) >> 16; }
#if defined(__HIP_DEVICE_COMPILE__)
typedef float pk_f32x2 __attribute__((ext_vector_type(2))); typedef __bf16 pk_bf16x2 __attribute__((ext_vector_type(2)));
__device__ __forceinline__ unsigned pk2(float lo, float hi) { const pk_f32x2 v = {lo, hi}; const pk_bf16x2 b = __builtin_convertvector(v, pk_bf16x2); return __builtin_bit_cast(unsigned, b); }
#else
__device__ __forceinline__ unsigned pk2(float lo, float hi) { return f2bf(lo) | (f2bf(hi) << 16); }
#endif
typedef unsigned v4u __attribute__((ext_vector_type(4)));
__device__ __forceinline__ void st_bf16x4(bf16_t* p, float4 v) { uint2 o; o.x = pk2(v.x, v.y); o.y = pk2(v.z, v.w); *(uint2*)p = o; }

__device__ __forceinline__ float wave_sum(float v) {
#pragma unroll
    for (int o = 1; o < 64; o <<= 1) v += __shfl_xor(v, o);
    return v;
}
__device__ __forceinline__ float wave_max(float v) {
#pragma unroll
    for (int o = 1; o < 64; o <<= 1) v = fmaxf(v, __shfl_xor(v, o));
    return v;
}
__device__ __forceinline__ float gelu_tanh(float x) { const float y2 = 1.5957691216057308f * (x + 0.044715f * x * x * x); return x * __builtin_amdgcn_rcpf(1.0f + __builtin_amdgcn_exp2f(-y2 * 1.4426950408889634f)); }
__device__ __forceinline__ float sigmoidf(float x) { return 1.0f / (1.0f + expf(-x)); }
__device__ __forceinline__ const float* xrow(const Ptrs& P, int m) { return m < MP ? P.xp + (size_t)m * D : P.xs + (size_t)(m - MP) * D; }

struct F8 { float v[8]; };
__device__ __forceinline__ F8 ld8f(const float* p) { const float4 a = *(const float4*)p, b = *(const float4*)(p + 4); F8 r; r.v[0] = a.x; r.v[1] = a.y; r.v[2] = a.z; r.v[3] = a.w; r.v[4] = b.x; r.v[5] = b.y; r.v[6] = b.z; r.v[7] = b.w; return r; }
__device__ __forceinline__ F8 ld8h(const bf16_t* p) { const v4u t = *(const v4u*)p; F8 r; r.v[0] = __builtin_bit_cast(float, t.x << 16); r.v[1] = __builtin_bit_cast(float, t.x & 0xffff0000u); r.v[2] = __builtin_bit_cast(float, t.y << 16); r.v[3] = __builtin_bit_cast(float, t.y & 0xffff0000u);
    r.v[4] = __builtin_bit_cast(float, t.z << 16); r.v[5] = __builtin_bit_cast(float, t.z & 0xffff0000u); r.v[6] = __builtin_bit_cast(float, t.w << 16); r.v[7] = __builtin_bit_cast(float, t.w & 0xffff0000u); return r; }
__device__ __forceinline__ void st8f(float* p, const F8& r) { *(float4*)p = make_float4(r.v[0], r.v[1], r.v[2], r.v[3]); *(float4*)(p + 4) = make_float4(r.v[4], r.v[5], r.v[6], r.v[7]); }
__device__ __forceinline__ void st8h(bf16_t* p, const F8& r) { v4u t; t.x = pk2(r.v[0], r.v[1]); t.y = pk2(r.v[2], r.v[3]); t.z = pk2(r.v[4], r.v[5]); t.w = pk2(r.v[6], r.v[7]); *(v4u*)p = t; }
template <int MODE, int U, int NS>
__device__ __forceinline__ void rms_rows(const Ptrs& P, int row_lo, int row_hi, int gwave, int nwaves, int lane) {
    for (int m0 = row_lo + gwave; m0 < row_hi; m0 += U * nwaves) {
        F8 v[U][4], a[U][4]; bool ok[U]; int mm[U];
#pragma unroll
        for (int u = 0; u < U; ++u) { const int m = m0 + u * nwaves; ok[u] = m < row_hi; mm[u] = ok[u] ? m : m0;
            const float* aux = xrow(P, mm[u]); const bf16_t* h1b = (const bf16_t*)(P.ws + W_H1) + (size_t)mm[u] * D;
#pragma unroll
            for (int j = 0; j < 4; ++j) { const int c = 8 * (64 * j + lane);
                if (MODE == 0) v[u][j] = ld8f(xrow(P, mm[u]) + c);
                else if (NS > 0) v[u][j] = ld8h((const bf16_t*)(P.ws + W_SLAB) + (size_t)(mm[u] - MP) * D + c);
                else v[u][j] = ld8h(P.tb + (size_t)mm[u] * D + c);
                if (MODE == 1) a[u][j] = ld8f(aux + c); else if (MODE == 2) a[u][j] = ld8h(h1b + c); }
#pragma unroll 5
            for (int k = 1; k < NS; ++k)
#pragma unroll
                for (int j = 0; j < 4; ++j) { const F8 t = ld8h((const bf16_t*)(P.ws + W_SLAB) + (size_t)k * MS * D + (size_t)(mm[u] - MP) * D + 8 * (64 * j + lane));
#pragma unroll
                    for (int e = 0; e < 8; ++e) v[u][j].v[e] += t.v[e]; } }
#pragma unroll
        for (int u = 0; u < U; ++u) {
            float ss = 0.f;
#pragma unroll
            for (int j = 0; j < 4; ++j)
#pragma unroll
                for (int e = 0; e < 8; ++e) ss += v[u][j].v[e] * v[u][j].v[e];
            ss = wave_sum(ss);
            const float r = rsqrtf(ss * (1.0f / D) + EPS); const int m = mm[u];
            if (MODE == 0) {
                if (ok[u]) {
#pragma unroll
                    for (int j = 0; j < 4; ++j) { const int c = 8 * (64 * j + lane); const F8 g = ld8f(P.g_pre + c); F8 o;
#pragma unroll
                        for (int e = 0; e < 8; ++e) o.v[e] = v[u][j].v[e] * r * g.v[e];
                        st8h(P.ub + (size_t)m * D + c, o); } }
            } else if (MODE == 1) {
                float s2 = 0.f;
#pragma unroll
                for (int j = 0; j < 4; ++j) { const int c = 8 * (64 * j + lane); const F8 g = ld8f(P.g_pmix + c); F8 o;
#pragma unroll
                    for (int e = 0; e < 8; ++e) { o.v[e] = a[u][j].v[e] + v[u][j].v[e] * r * g.v[e]; s2 += o.v[e] * o.v[e]; }
                    if (ok[u]) st8h((bf16_t*)(P.ws + W_H1) + (size_t)m * D + c, o); v[u][j] = o; }
                s2 = wave_sum(s2); const float r2 = rsqrtf(s2 * (1.0f / D) + EPS);
                if (ok[u]) {
#pragma unroll
                    for (int j = 0; j < 4; ++j) { const int c = 8 * (64 * j + lane); const F8 g = ld8f(P.g_pffn + c); F8 o;
#pragma unroll
                        for (int e = 0; e < 8; ++e) o.v[e] = v[u][j].v[e] * r2 * g.v[e];
                        st8h(P.u2b + (size_t)m * D + c, o); } }
            } else {
                float* orow = m < MP ? P.out + O_YP + (size_t)m * D : P.out + O_YS + (size_t)(m - MP) * D;
                if (ok[u]) {
#pragma unroll
                    for (int j = 0; j < 4; ++j) { const int c = 8 * (64 * j + lane); const F8 g = ld8f(P.g_postffn + c); F8 o;
#pragma unroll
                        for (int e = 0; e < 8; ++e) o.v[e] = a[u][j].v[e] + v[u][j].v[e] * r * g.v[e];
                        st8f(orow + c, o); } }
            }
        }
    }
}
template <int MODE>
__device__ __forceinline__ void rms_stage(const Ptrs& P, int gwave, int nwaves, int lane) {
    if (MODE == 0) rms_rows<0, 2, 0>(P, 0, M, gwave, nwaves, lane);
    else { rms_rows<MODE, 2, 0>(P, 0, MP, gwave, nwaves, lane);
           rms_rows<MODE, 1, (MODE == 1 ? 8 : 11)>(P, MP, M, (gwave & 7) * (nwaves >> 3) + (gwave >> 3), nwaves, lane); }
}

struct TrItem { const float* src; int ldw; bf16_t* dst; int K; };
__device__ __forceinline__ TrItem tr_decode(const Ptrs& P, int it, int lane) {
    constexpr int I_A = (D / 64) * (3584 / 32), I_MG = (D / 64) * (4096 / 32), I_N = (1024 / 64) * (D / 32), I_O = (D / 64) * (D / 32), I_UP = (D / 64) * (2 * FF / 32);
    const float* W; int ldw, nblk, K; bf16_t* WT; int r = it; bool upmap = false;
    if (r < I_A) { W = P.w_in; ldw = INW; nblk = 3584 / 32; K = D; WT = P.wt_in; }
    else if ((r -= I_A) < I_MG) { W = P.w_in + ZMG; ldw = INW; nblk = 4096 / 32; K = D; WT = P.wt_in + (size_t)3584 * D; }
    else if ((r -= I_MG) < I_N) { W = P.w_nproj; ldw = D; nblk = D / 32; K = D; WT = P.wt_pn + 1024; }
    else if ((r -= I_N) < I_O) { W = P.w_out; ldw = D; nblk = D / 32; K = D; WT = P.wt_out; }
    else if ((r -= I_O) < I_UP) { W = P.w_up; ldw = 2 * FF; nblk = 2 * FF / 32; K = D; WT = P.wt_up; upmap = true; }
    else { r -= I_UP; W = P.w_down; ldw = D; nblk = D / 32; K = FF; WT = P.wt_down; }
    const int kb = r / nblk, nb = r % nblk, k0 = 64 * kb, n0 = 32 * nb;
    int nd = n0;
    if (upmap) { const int half = n0 >= FF, f0 = half ? n0 - FF : n0; nd = (f0 >> 7) * 256 + half * 128 + (f0 & 127); }
    TrItem t; t.src = W + (size_t)(k0 + (lane >> 3)) * ldw + n0 + (lane & 7) * 4; t.ldw = ldw; t.dst = WT + (size_t)nd * K + k0; t.K = K; return t;
}
constexpr int TR_P0 = (D / 64) * (3584 / 32) + (D / 64) * (4096 / 32) + (1024 / 64) * (D / 32), TR_O = TR_P0 + (D / 64) * (D / 32), TR_UP = TR_O + (D / 64) * (2 * FF / 32), TR_ALL = TR_UP + (FF / 64) * (D / 32);
constexpr int TR_SLOTA = TR_O + 5120;
__device__ __forceinline__ void prologue_transposes(const Ptrs& P, unsigned char* lds, int it_lo, int it_hi, int gwave, int nwaves, int wave, int lane) {
    LAS float* scr = (LAS float*)((LAS unsigned char*)lds + wave * 16384);
    const int NITEMS = it_hi;
    const int kk = lane >> 3, n4 = (lane & 7) * 4, c = lane & 7;
    int it = it_lo + gwave; if (it >= NITEMS) return;
    TrItem cur = tr_decode(P, it, lane);
    float4 x[8];
#pragma unroll
    for (int i = 0; i < 8; ++i) x[i] = *(const float4*)(cur.src + (size_t)(8 * i) * cur.ldw);
    for (;;) {
        const int itn = it + nwaves; const bool more = itn < NITEMS;
        const TrItem nxt = tr_decode(P, more ? itn : it, lane);
        float4 xn[8];
#pragma unroll
        for (int i = 0; i < 8; ++i) xn[i] = *(const float4*)(nxt.src + (size_t)(8 * i) * nxt.ldw);
#pragma unroll
        for (int i = 0; i < 8; ++i) { LAS float* d = scr + (kk + 8 * i) * 33 + n4; d[0] = x[i].x; d[1] = x[i].y; d[2] = x[i].z; d[3] = x[i].w; }
        asm volatile("s_waitcnt lgkmcnt(0)" ::: "memory");
#pragma unroll
        for (int j = 0; j < 4; ++j) { const int n = (lane >> 3) + 8 * j; const LAS float* sp = scr + (8 * c) * 33 + n;
            v4u o; o.x = pk2(sp[0 * 33], sp[1 * 33]); o.y = pk2(sp[2 * 33], sp[3 * 33]); o.z = pk2(sp[4 * 33], sp[5 * 33]); o.w = pk2(sp[6 * 33], sp[7 * 33]);
            *(v4u*)(cur.dst + (size_t)n * cur.K + 8 * c) = o; }
        asm volatile("s_waitcnt lgkmcnt(0)" ::: "memory");
        if (!more) break;
#pragma unroll
        for (int i = 0; i < 8; ++i) x[i] = xn[i];
        cur = nxt; it = itn;
    }
}
__device__ __forceinline__ void prologue_ng(const Ptrs& P, size_t gtid, size_t nthr) {
    for (size_t i = gtid; i < (size_t)64 * D; i += nthr) { const int n = (int)(i >> 11), k = (int)(i & 2047); P.wt_ng[i] = (bf16_t)(n < 48 ? f2bf(P.w_in[(size_t)k * INW + ZNG + n]) : 0u); }
}
__device__ __forceinline__ void prologue_wprime(const Ptrs& P, float* lds, int bid, int nblk, int tid) {
    float (*As)[68] = (float (*)[68])lds; float (*Bs)[132] = (float (*)[132])(lds + 16 * 68);
    const int ty = tid >> 5, tx = tid & 31;
    for (int tile = bid; tile < 256; tile += nblk) {
        const int gi = tile >> 6, tm = (tile >> 4) & 3, tn = tile & 15;
        const float* A = P.w_pgrp + (size_t)gi * 65536; const float* B = P.w_pproj + (size_t)gi * 256 * D; const float* ks = P.pool_scale + gi * 256;
        float acc[4][4];
#pragma unroll
        for (int i = 0; i < 4; ++i)
#pragma unroll
            for (int j = 0; j < 4; ++j) acc[i][j] = 0.f;
        const int ar = (tid >> 2) & 63, akq = (tid & 3) * 4; const int bk = tid >> 5, bn = (tid & 31) * 4;
        for (int k0 = 0; k0 < 256; k0 += 16) {
            float4 av = *(const float4*)(A + (size_t)(tm * 64 + ar) * 256 + k0 + akq); const float4 sv = *(const float4*)(ks + k0 + akq);
            av.x *= sv.x; av.y *= sv.y; av.z *= sv.z; av.w *= sv.w;
            const float4 bv = *(const float4*)(B + (size_t)(k0 + bk) * D + tn * 128 + bn);
            __syncthreads();
            if (tid < 256) { As[akq + 0][ar] = av.x; As[akq + 1][ar] = av.y; As[akq + 2][ar] = av.z; As[akq + 3][ar] = av.w; }
            *(float4*)&Bs[bk][bn] = bv;
            __syncthreads();
#pragma unroll
            for (int k = 0; k < 16; ++k) {
                const float4 a0 = *(const float4*)&As[k][ty * 4], b = *(const float4*)&Bs[k][tx * 4];
                const float a[4] = {a0.x, a0.y, a0.z, a0.w}; const float bb[4] = {b.x, b.y, b.z, b.w};
#pragma unroll
                for (int i = 0; i < 4; ++i)
#pragma unroll
                    for (int j = 0; j < 4; ++j) acc[i][j] = fmaf(a[i], bb[j], acc[i][j]);
            }
        }
#pragma unroll
        for (int j = 0; j < 4; ++j) { const int col = tn * 128 + tx * 4 + j; const int row = gi * 256 + tm * 64 + ty * 4;
            uint2 o; o.x = pk2(acc[0][j], acc[1][j]); o.y = pk2(acc[2][j], acc[3][j]); *(uint2*)(P.wt_pn + (size_t)col * D + row) = o; }
    }
}
typedef short bf16x8_t __attribute__((ext_vector_type(8)));
typedef float f32x4_t __attribute__((ext_vector_type(4)));
__device__ __forceinline__ void ng_stage(const Ptrs& P, int bid, int nblk, int wave, int lane) {
    const int r16 = lane & 15, kq = lane >> 4;
    for (int task = wave * nblk + bid; task < M / 16; task += 8 * nblk) {
        const bf16_t* arow = P.ub + (size_t)(task * 16 + r16) * D + 8 * kq;
        const bf16_t* brow = P.wt_ng + (size_t)r16 * D + 8 * kq;
        f32x4_t acc[3] = {{0.f, 0.f, 0.f, 0.f}, {0.f, 0.f, 0.f, 0.f}, {0.f, 0.f, 0.f, 0.f}};
#pragma unroll 4
        for (int ks = 0; ks < D / 32; ++ks) {
            const bf16x8_t a = *(const bf16x8_t*)(arow + 32 * ks);
#pragma unroll
            for (int nt = 0; nt < 3; ++nt) { const bf16x8_t b = *(const bf16x8_t*)(brow + (size_t)nt * 16 * D + 32 * ks); acc[nt] = __builtin_amdgcn_mfma_f32_16x16x32_bf16(a, b, acc[nt], 0, 0, 0); }
        }
#pragma unroll
        for (int nt = 0; nt < 3; ++nt)
#pragma unroll
            for (int r = 0; r < 4; ++r) P.ngs[(size_t)(task * 16 + kq * 4 + r) * 48 + nt * 16 + r16] = sigmoidf(acc[nt][r]);
    }
}
template <int R, bool PROMPT>
__device__ __forceinline__ void compress_mfma(const Ptrs& P, int gwave, int nwaves, int lane) {
    const int r16 = lane & 15, kq = lane >> 4, n4 = r16 >> 2, g = r16 & 3;
    const int ntask = (PROMPT ? BP * 16 : BS * 16) / R * 2;
    for (int task = gwave; task < ntask; task += nwaves) {
        const int slot = task & 1, pgp = task >> 1;
        const float* rowp[R]; int obase[R]; int stride;
#pragma unroll
        for (int rr = 0; rr < R; ++rr) { const int pgi = pgp * R + rr, b = pgi >> 4, pg = pgi & 15;
            if (PROMPT) { stride = 1024; rowp[rr] = P.out + O_KVP + (size_t)(b * TP + pg * 128 + n4 * 32) * 1024 + slot * 256 + g * 64 + 8 * kq; obase[rr] = (((b) * 64 + pg * 4 + n4) * 4 + g) * 64; }
            else { stride = 1024; const int page = P.pt[b * 16 + pg]; rowp[rr] = P.cache + ((size_t)page * 128 + n4 * 32) * 1024 + slot * 256 + g * 64 + 8 * kq; obase[rr] = (((BP + b) * 64 + pg * 4 + n4) * 4 + g) * 64; } }
        f32x4_t acc[R][4];
#pragma unroll
        for (int rr = 0; rr < R; ++rr)
#pragma unroll
            for (int nt = 0; nt < 4; ++nt) acc[rr][nt] = (f32x4_t){0.f, 0.f, 0.f, 0.f};
        const bf16_t* w1f = P.w1f + (size_t)slot * 64 * 4 * 512 + lane * 8;
#pragma unroll 4
        for (int ks = 0; ks < 64; ++ks) {
            bf16x8_t a[4];
#pragma unroll
            for (int nt = 0; nt < 4; ++nt) a[nt] = *(const bf16x8_t*)(w1f + (size_t)(ks * 4 + nt) * 512);
            const size_t off = (size_t)(ks >> 1) * stride + (ks & 1) * 32;
#pragma unroll
            for (int rr = 0; rr < R; ++rr) {
                const float4 x0 = *(const float4*)(rowp[rr] + off), x1 = *(const float4*)(rowp[rr] + off + 4);
                v4u t; t.x = pk2(x0.x, x0.y); t.y = pk2(x0.z, x0.w); t.z = pk2(x1.x, x1.y); t.w = pk2(x1.z, x1.w);
                const bf16x8_t bfr = __builtin_bit_cast(bf16x8_t, t);
#pragma unroll
                for (int nt = 0; nt < 4; ++nt) acc[rr][nt] = __builtin_amdgcn_mfma_f32_16x16x32_bf16(a[nt], bfr, acc[rr][nt], 0, 0, 0);
            }
        }
        const float* c1 = P.c1 + slot * 64 + 4 * kq;
        const bf16_t* w2f = P.w2f + (size_t)slot * 2 * 4 * 512 + lane * 8;
#pragma unroll
        for (int rr = 0; rr < R; ++rr) {
            bf16x8_t hb[2];
#pragma unroll
            for (int k2 = 0; k2 < 2; ++k2) { float hv[8];
#pragma unroll
                for (int j = 0; j < 8; ++j) { const int nt = 2 * k2 + (j >> 2); hv[j] = gelu_tanh(acc[rr][nt][j & 3] + c1[16 * nt + (j & 3)]); }
                v4u t; t.x = pk2(hv[0], hv[1]); t.y = pk2(hv[2], hv[3]); t.z = pk2(hv[4], hv[5]); t.w = pk2(hv[6], hv[7]); hb[k2] = __builtin_bit_cast(bf16x8_t, t); }
#pragma unroll
            for (int ft = 0; ft < 4; ++ft) { f32x4_t o2 = (f32x4_t){0.f, 0.f, 0.f, 0.f};
#pragma unroll
                for (int k2 = 0; k2 < 2; ++k2) o2 = __builtin_amdgcn_mfma_f32_16x16x32_bf16(*(const bf16x8_t*)(w2f + (size_t)(k2 * 4 + ft) * 512), hb[k2], o2, 0, 0, 0);
                const int oi = obase[rr] + 16 * ft + 4 * kq;
                uint2 w; w.x = pk2(o2[0], o2[1]); w.y = pk2(o2[2], o2[3]); *(uint2*)((slot ? P.vcb : P.kcb) + oi) = w; }
        }
    }
}
__device__ __forceinline__ void compress_sample_lds(const Ptrs& P, LAS unsigned char* L, int bid, int nblk, int wave, int lane, int tid) {
    constexpr int R = 2, NTASK = BS * 16 / R * 2;
    const int r16 = lane & 15, kq = lane >> 4, n4 = r16 >> 2, g = r16 & 3;
    for (int base = bid * 8; base < NTASK; base += nblk * 8) {
        const int task = base + wave; const bool valid = task < NTASK; const int tk = valid ? task : NTASK - 2 + (wave & 1);
        const int slot = tk & 1, pgp = tk >> 1;
        const float* rowp[R];
#pragma unroll
        for (int rr = 0; rr < R; ++rr) { const int pgi = pgp * R + rr, b = pgi >> 4, pg = pgi & 15; const int page = P.pt[b * 16 + pg];
            rowp[rr] = P.cache + ((size_t)page * 128 + n4 * 32) * 1024 + slot * 256 + g * 64 + 8 * kq; }
        f32x4_t acc[R][4];
#pragma unroll
        for (int rr = 0; rr < R; ++rr)
#pragma unroll
            for (int nt = 0; nt < 4; ++nt) acc[rr][nt] = (f32x4_t){0.f, 0.f, 0.f, 0.f};
        const bf16_t* wsrc0 = P.w1f + (size_t)tid * 8;
        v4u wr[4];
#pragma unroll
        for (int c = 0; c < 4; ++c) wr[c] = *(const v4u*)(wsrc0 + (size_t)((c >> 1) * 64) * 4 * 512 + (c & 1) * 4096);
        __syncthreads();
#pragma unroll
        for (int c = 0; c < 4; ++c) *(LAS v4u*)(L + (c >> 1) * 16384 + (c & 1) * 8192 + tid * 16) = wr[c];
        __syncthreads();
        for (int kb = 0; kb < 16; ++kb) {
            const int kn = (kb < 15) ? kb + 1 : kb;
#pragma unroll
            for (int c = 0; c < 4; ++c) wr[c] = *(const v4u*)(wsrc0 + (size_t)((c >> 1) * 64 + 4 * kn) * 4 * 512 + (c & 1) * 4096);
            float4 x[4][R][2];
#pragma unroll
            for (int q = 0; q < 4; ++q)
#pragma unroll
                for (int rr = 0; rr < R; ++rr) { const size_t off = (size_t)(2 * kb + (q >> 1)) * 1024 + (q & 1) * 32; x[q][rr][0] = *(const float4*)(rowp[rr] + off); x[q][rr][1] = *(const float4*)(rowp[rr] + off + 4); }
            const LAS unsigned char* wb = L + (kb & 1) * 32768 + slot * 16384 + lane * 16;
#pragma unroll
            for (int q = 0; q < 4; ++q) {
                bf16x8_t a[4];
#pragma unroll
                for (int nt = 0; nt < 4; ++nt) a[nt] = *(const LAS bf16x8_t*)(wb + (q * 4 + nt) * 1024);
#pragma unroll
                for (int rr = 0; rr < R; ++rr) {
                    const float4 x0 = x[q][rr][0], x1 = x[q][rr][1];
                    v4u t; t.x = pk2(x0.x, x0.y); t.y = pk2(x0.z, x0.w); t.z = pk2(x1.x, x1.y); t.w = pk2(x1.z, x1.w);
                    const bf16x8_t bfr = __builtin_bit_cast(bf16x8_t, t);
#pragma unroll
                    for (int nt = 0; nt < 4; ++nt) acc[rr][nt] = __builtin_amdgcn_mfma_f32_16x16x32_bf16(a[nt], bfr, acc[rr][nt], 0, 0, 0);
                }
            }
#pragma unroll
            for (int c = 0; c < 4; ++c) *(LAS v4u*)(L + ((kb + 1) & 1) * 32768 + (c >> 1) * 16384 + (c & 1) * 8192 + tid * 16) = wr[c];
            __syncthreads();
        }
        int l2; asm volatile("v_mbcnt_lo_u32_b32 %0, -1, 0\n\tv_mbcnt_hi_u32_b32 %0, -1, %0" : "=v"(l2) :: "memory");
        const int kq2 = l2 >> 4, r2 = l2 & 15;
        const float* c1 = P.c1 + slot * 64 + 4 * kq2;
        const bf16_t* w2f = P.w2f + (size_t)slot * 2 * 4 * 512 + l2 * 8;
#pragma unroll
        for (int rr = 0; rr < R; ++rr) {
            const int pgi = pgp * R + rr, b = pgi >> 4, pg = pgi & 15; const int ob = (((BP + b) * 64 + pg * 4 + (r2 >> 2)) * 4 + (r2 & 3)) * 64;
            bf16x8_t hb[2];
#pragma unroll
            for (int k2 = 0; k2 < 2; ++k2) { float hv[8];
#pragma unroll
                for (int j = 0; j < 8; ++j) { const int nt = 2 * k2 + (j >> 2); hv[j] = gelu_tanh(acc[rr][nt][j & 3] + c1[16 * nt + (j & 3)]); }
                v4u t; t.x = pk2(hv[0], hv[1]); t.y = pk2(hv[2], hv[3]); t.z = pk2(hv[4], hv[5]); t.w = pk2(hv[6], hv[7]); hb[k2] = __builtin_bit_cast(bf16x8_t, t); }
#pragma unroll
            for (int ft = 0; ft < 4; ++ft) { f32x4_t o2 = (f32x4_t){0.f, 0.f, 0.f, 0.f};
#pragma unroll
                for (int k2 = 0; k2 < 2; ++k2) o2 = __builtin_amdgcn_mfma_f32_16x16x32_bf16(*(const bf16x8_t*)(w2f + (size_t)(k2 * 4 + ft) * 512), hb[k2], o2, 0, 0, 0);
                const int oi = ob + 16 * ft + 4 * kq2;
                uint2 w; w.x = pk2(o2[0], o2[1]); w.y = pk2(o2[2], o2[3]); if (valid) *(uint2*)((slot ? P.vcb : P.kcb) + oi) = w; }
        }
    }
}
__device__ __forceinline__ void compress_prompt_split(const Ptrs& P, LAS unsigned char* L, int bid, int wave, int lane) {
    const int r16 = lane & 15, kq = lane >> 4, n4 = r16 >> 2, g = r16 & 3;
    const int task = bid * 4 + (wave >> 1), kh = wave & 1, slot = task & 1, pgi = task >> 1, b = pgi >> 4, pg = pgi & 15;
    const float* rowp = P.out + O_KVP + (size_t)(b * TP + pg * 128 + n4 * 32) * 1024 + slot * 256 + g * 64 + 8 * kq;
    f32x4_t acc[4];
#pragma unroll
    for (int nt = 0; nt < 4; ++nt) acc[nt] = (f32x4_t){0.f, 0.f, 0.f, 0.f};
    const bf16_t* w1f = P.w1f + (size_t)slot * 64 * 4 * 512 + lane * 8;
#pragma unroll 4
    for (int kk = 0; kk < 32; ++kk) { const int ks = 32 * kh + kk;
        bf16x8_t a[4];
#pragma unroll
        for (int nt = 0; nt < 4; ++nt) a[nt] = *(const bf16x8_t*)(w1f + (size_t)(ks * 4 + nt) * 512);
        const size_t off = (size_t)(ks >> 1) * 1024 + (ks & 1) * 32;
        const float4 x0 = *(const float4*)(rowp + off), x1 = *(const float4*)(rowp + off + 4);
        v4u t; t.x = pk2(x0.x, x0.y); t.y = pk2(x0.z, x0.w); t.z = pk2(x1.x, x1.y); t.w = pk2(x1.z, x1.w);
        const bf16x8_t bfr = __builtin_bit_cast(bf16x8_t, t);
#pragma unroll
        for (int nt = 0; nt < 4; ++nt) acc[nt] = __builtin_amdgcn_mfma_f32_16x16x32_bf16(a[nt], bfr, acc[nt], 0, 0, 0);
    }
    LAS f32x4_t* X = (LAS f32x4_t*)(L + (wave >> 1) * 4096) + lane;
    __syncthreads();
    if (kh == 1) {
#pragma unroll
        for (int nt = 0; nt < 4; ++nt) X[nt * 64] = acc[nt]; }
    __syncthreads();
    if (kh == 0) {
#pragma unroll
        for (int nt = 0; nt < 4; ++nt) acc[nt] += X[nt * 64];
        const float* c1 = P.c1 + slot * 64 + 4 * kq; const bf16_t* w2f = P.w2f + (size_t)slot * 2 * 4 * 512 + lane * 8;
        const int ob = (((b) * 64 + pg * 4 + n4) * 4 + g) * 64;
        bf16x8_t hb[2];
#pragma unroll
        for (int k2 = 0; k2 < 2; ++k2) { float hv[8];
#pragma unroll
            for (int j = 0; j < 8; ++j) { const int nt = 2 * k2 + (j >> 2); hv[j] = gelu_tanh(acc[nt][j & 3] + c1[16 * nt + (j & 3)]); }
            v4u t; t.x = pk2(hv[0], hv[1]); t.y = pk2(hv[2], hv[3]); t.z = pk2(hv[4], hv[5]); t.w = pk2(hv[6], hv[7]); hb[k2] = __builtin_bit_cast(bf16x8_t, t); }
#pragma unroll
        for (int ft = 0; ft < 4; ++ft) { f32x4_t o2 = (f32x4_t){0.f, 0.f, 0.f, 0.f};
#pragma unroll
            for (int k2 = 0; k2 < 2; ++k2) o2 = __builtin_amdgcn_mfma_f32_16x16x32_bf16(*(const bf16x8_t*)(w2f + (size_t)(k2 * 4 + ft) * 512), hb[k2], o2, 0, 0, 0);
            const int oi = ob + 16 * ft + 4 * kq;
            uint2 w; w.x = pk2(o2[0], o2[1]); w.y = pk2(o2[2], o2[3]); *(uint2*)((slot ? P.vcb : P.kcb) + oi) = w; }
    }
}
__device__ __forceinline__ void prologue_cmp(const Ptrs& P, size_t gtid, size_t nthr, int gwave, int nwaves, int lane) {
    for (size_t i = gtid; i < (size_t)2 * 64 * 4 * 64; i += nthr) { const int ln = (int)(i & 63), nt = (int)((i >> 6) & 3), ks = (int)((i >> 8) & 63), slot = (int)(i >> 14);
        const float* w1 = slot ? P.w1_v : P.w1_k; const int e = 16 * nt + (ln & 15), k0 = 32 * ks + 8 * (ln >> 4);
        v4u t; t.x = pk2(w1[(size_t)(k0 + 0) * 64 + e], w1[(size_t)(k0 + 1) * 64 + e]); t.y = pk2(w1[(size_t)(k0 + 2) * 64 + e], w1[(size_t)(k0 + 3) * 64 + e]);
        t.z = pk2(w1[(size_t)(k0 + 4) * 64 + e], w1[(size_t)(k0 + 5) * 64 + e]); t.w = pk2(w1[(size_t)(k0 + 6) * 64 + e], w1[(size_t)(k0 + 7) * 64 + e]);
        *(v4u*)(P.w1f + i * 8) = t; }
    for (size_t i = gtid; i < (size_t)2 * 2 * 4 * 64; i += nthr) { const int ln = (int)(i & 63), ft = (int)((i >> 6) & 3), k2 = (int)((i >> 8) & 1), slot = (int)(i >> 9);
        const float* w2 = slot ? P.w2_v : P.w2_k; const int f = 16 * ft + (ln & 15); float v[8];
#pragma unroll
        for (int j = 0; j < 8; ++j) v[j] = w2[(size_t)(16 * (2 * k2 + (j >> 2)) + 4 * (ln >> 4) + (j & 3)) * 64 + f];
        v4u t; t.x = pk2(v[0], v[1]); t.y = pk2(v[2], v[3]); t.z = pk2(v[4], v[5]); t.w = pk2(v[6], v[7]); *(v4u*)(P.w2f + i * 8) = t; }
    { const int nblk_ = nwaves >> 3, bid_ = gwave >> 3, wv_ = gwave & 7;
      for (int it = wv_ * nblk_ + bid_; it < 128; it += nwaves) { const int slot = it >> 6, e = it & 63; const float* w1 = slot ? P.w1_v : P.w1_k; const float* pe = slot ? P.pe_v : P.pe_k;
        float sacc = 0.f;
        for (int k0 = 0; k0 < 2048; k0 += 512) { float pv[8], wv[8];
#pragma unroll
            for (int i = 0; i < 8; ++i) { const int k = k0 + 64 * i + lane; pv[i] = pe[k]; wv[i] = w1[(size_t)k * 64 + e]; }
#pragma unroll
            for (int i = 0; i < 8; ++i) sacc = fmaf(pv[i], wv[i], sacc); }
        sacc = wave_sum(sacc); if (lane == 0) P.c1[it] = sacc; } }
}
typedef float f32x16_t __attribute__((ext_vector_type(16)));
typedef short v4i16_t __attribute__((ext_vector_type(4)));
constexpr float LOG2E = 1.4426950408889634f;
constexpr float QSCALE = 0.125f * LOG2E;
constexpr int A_K0 = 0, A_V0 = 8192, A_K1 = 16384, A_V1 = 24576, A_BT = 32768, A_SEL = 34816, A_UNION = 35072, A_IMP = 36864, A_RB = A_IMP + 4 * 64 * 32 * 4, A_END = A_RB + 4 * 4 * 256 * 4;
__device__ __forceinline__ int crow(int r, int hi) { return (r & 3) + 8 * (r >> 2) + 4 * hi; }
__device__ __forceinline__ unsigned cvtpk(float lo, float hi) { unsigned r; asm volatile("v_cvt_pk_bf16_f32 %0, %1, %2" : "=v"(r) : "v"(lo), "v"(hi)); return r; }

__device__ __forceinline__ void qk_tile(f32x16_t& s0, f32x16_t& s1, const LAS unsigned char* kb, const bf16x8_t (&qf)[4], int r32, int hi, float init = 0.f) {
#pragma unroll
    for (int r = 0; r < 16; ++r) { s0[r] = init; s1[r] = init; }
#pragma unroll
    for (int d0 = 0; d0 < 4; ++d0) {
        const int c = 2 * d0 + hi;
        const bf16x8_t a0 = *(const LAS bf16x8_t*)(kb + c * 1024 + ((r32 ^ c) * 16));
        const bf16x8_t a1 = *(const LAS bf16x8_t*)(kb + c * 1024 + 512 + ((r32 ^ c) * 16));
        s0 = __builtin_amdgcn_mfma_f32_32x32x16_bf16(a0, qf[d0], s0, 0, 0, 0);
        s1 = __builtin_amdgcn_mfma_f32_32x32x16_bf16(a1, qf[d0], s1, 0, 0, 0);
    }
}
__device__ __forceinline__ void pv_tile(f32x16_t (&o)[2], const LAS unsigned char* vb, const f32x16_t& p0, const f32x16_t& p1, int lane) {
    bf16x8_t pf[4];
#pragma unroll
    for (int s = 0; s < 4; ++s) {
        const int base = 8 * (s & 1);
        unsigned w[4];
#pragma unroll
        for (int k = 0; k < 4; ++k) w[k] = (s < 2) ? cvtpk(p0[base + 2 * k], p0[base + 2 * k + 1]) : cvtpk(p1[base + 2 * k], p1[base + 2 * k + 1]);
        v4u t; t.x = w[0]; t.y = w[1]; t.z = w[2]; t.w = w[3]; pf[s] = __builtin_bit_cast(bf16x8_t, t);
    }
    const LAS unsigned char* va = vb + ((lane >> 4) & 1) * 32 + (lane & 3) * 8 + (4 * (lane >> 5) + ((lane & 15) >> 2)) * 64;
#pragma unroll
    for (int dd = 0; dd < 2; ++dd)
#pragma unroll
        for (int s = 0; s < 4; ++s) {
            const v4i16_t lo = __builtin_amdgcn_ds_read_tr16_b64_v4i16((LAS v4i16_t*)(va + dd * 4096 + s * 1024));
            const v4i16_t hh = __builtin_amdgcn_ds_read_tr16_b64_v4i16((LAS v4i16_t*)(va + dd * 4096 + s * 1024 + 512));
            const bf16x8_t vf = (bf16x8_t){lo[0], lo[1], lo[2], lo[3], hh[0], hh[1], hh[2], hh[3]};
            o[dd] = __builtin_amdgcn_mfma_f32_32x32x16_bf16(vf, pf[s], o[dd], 0, 0, 0);
        }
}
__device__ __forceinline__ v4u ld_k16(const bf16_t* src, int stride, int wave, int lane) { const int t = wave * 64 + lane; return *(const v4u*)(src + (size_t)(t >> 3) * stride + (t & 7) * 8); }
__device__ __forceinline__ v4u ld_v16(const bf16_t* src, int stride, int tid) { return *(const v4u*)(src + (size_t)(tid >> 3) * stride + (tid & 7) * 8); }
__device__ __forceinline__ void st_k16(LAS unsigned char* kb, v4u v, int wave, int lane) { const int t = wave * 64 + lane, key = t >> 3, c = t & 7; *(LAS v4u*)(kb + c * 1024 + ((key ^ c) * 16)) = v; }
__device__ __forceinline__ void st_v16(LAS unsigned char* vb, v4u v, int tid) { const int key = tid >> 3, c = tid & 7; *(LAS v4u*)(vb + (c >> 2) * 4096 + (key >> 3) * 512 + (key & 7) * 64 + (c & 3) * 16) = v; }

__device__ __forceinline__ float half_max(float v) { const auto rr = __builtin_amdgcn_permlane32_swap(__builtin_bit_cast(unsigned, v), __builtin_bit_cast(unsigned, v), false, false); return fmaxf(__builtin_bit_cast(float, (unsigned)rr[0]), __builtin_bit_cast(float, (unsigned)rr[1])); }
__device__ __forceinline__ float half_sum(float v) { const auto rr = __builtin_amdgcn_permlane32_swap(__builtin_bit_cast(unsigned, v), __builtin_bit_cast(unsigned, v), false, false); return __builtin_bit_cast(float, (unsigned)rr[0]) + __builtin_bit_cast(float, (unsigned)rr[1]); }

typedef float f32x2_t __attribute__((ext_vector_type(2)));
__device__ __forceinline__ f32x2_t pk_sub(f32x2_t a, f32x2_t b) { f32x2_t r; asm("v_pk_add_f32 %0, %1, %2 neg_lo:[0,1] neg_hi:[0,1]" : "=v"(r) : "v"(a), "v"(b)); return r; }
__device__ __forceinline__ float max3f(float a, float b, float c) { float r; asm("v_max3_f32 %0, %1, %2, %3" : "=v"(r) : "v"(a), "v"(b), "v"(c)); return r; }
__device__ __forceinline__ void softmax_pv(f32x16_t& s0, f32x16_t& s1, float& m_run, float& l_run, f32x16_t (&o)[2], const LAS unsigned char* vb, int lane, float tbias = 0.f) {
    float tm = -INFINITY, tm2 = -INFINITY;
#pragma unroll
    for (int r = 0; r < 16; r += 2) { tm = max3f(tm, s0[r], s1[r]); tm2 = max3f(tm2, s0[r + 1], s1[r + 1]); }
    tm = half_max(max3f(tm, tm2, tm2)) + tbias;
    const float m_new = fmaxf(m_run, tm);
    const float m_use = (m_new == -INFINITY) ? 0.f : m_new;
    const float alpha = __builtin_amdgcn_exp2f(m_run - m_use);
    { const float ms = m_use - tbias; const f32x2_t mm = {ms, ms};
#pragma unroll
      for (int r = 0; r < 16; r += 2) { const f32x2_t d0 = pk_sub(f32x2_t{s0[r], s0[r + 1]}, mm), d1 = pk_sub(f32x2_t{s1[r], s1[r + 1]}, mm);
          s0[r] = __builtin_amdgcn_exp2f(d0[0]); s0[r + 1] = __builtin_amdgcn_exp2f(d0[1]); s1[r] = __builtin_amdgcn_exp2f(d1[0]); s1[r + 1] = __builtin_amdgcn_exp2f(d1[1]); } }
    float rs;
    { typedef float f32x8_t __attribute__((ext_vector_type(8)));
      const f32x16_t ps = s0 + s1;
      const f32x8_t a8 = __builtin_shufflevector(ps, ps, 0, 1, 2, 3, 4, 5, 6, 7) + __builtin_shufflevector(ps, ps, 8, 9, 10, 11, 12, 13, 14, 15);
      const f32x4_t a4 = __builtin_shufflevector(a8, a8, 0, 1, 2, 3) + __builtin_shufflevector(a8, a8, 4, 5, 6, 7);
      const f32x2_t a2 = __builtin_shufflevector(a4, a4, 0, 1) + __builtin_shufflevector(a4, a4, 2, 3);
      rs = a2[0] + a2[1]; }
    rs = half_sum(rs);
    l_run = l_run * alpha + rs; m_run = m_new;
    if (__any(alpha != 1.0f)) {
#pragma unroll
        for (int r = 0; r < 16; ++r) { o[0][r] *= alpha; o[1][r] *= alpha; } }
    pv_tile(o, vb, s0, s1, lane);
}

__device__ __forceinline__ void attn_prompt_unit(const Ptrs& P, LAS unsigned char* L, int b, int g, int qb, int tid_param, bool fill) {
    const int tid_in = tid_param;
    const int wave = __builtin_amdgcn_readfirstlane(tid_in >> 6), hh = wave >> 1, th = wave & 1, m0 = b * TP + 64 * qb, h = g * 4 + hh;
    bf16x8_t qf[4]; f32x16_t oacc[2], o[2], s0, s1;
    {
    int tid = tid_in; asm volatile("" : "+v"(tid));
    const int lane = tid & 63, r32 = lane & 31, hi = lane >> 5;
    const int tl = 32 * th + r32, t = 64 * qb + tl;
    LAS float* BT = (LAS float*)(L + A_BT); LAS unsigned* SEL = (LAS unsigned*)(L + A_SEL); LAS unsigned* UNI = (LAS unsigned*)(L + A_UNION); LAS float* IMP = (LAS float*)(L + A_IMP);
    const float NEG = -INFINITY;
    __syncthreads();
    if (fill) BT[tid] = P.rel_bias[BUCKET[tid & 127] * 16 + g * 4 + (tid >> 7)] * LOG2E;
    if (fill) { LAS float* RB = (LAS float*)(L + A_RB);
#pragma unroll 2
      for (int k = 0; k < 8; ++k) { const int e = tid + 512 * k, z = e & 255, a = (e >> 8) & 3, hd = e >> 10; const int d = 191 - (z + a);
          RB[e] = (d < 0) ? -INFINITY : P.rel_bias[BUCKET[d > 127 ? 127 : d] * 16 + g * 4 + hd] * LOG2E; } }
    if (tid == 0) UNI[0] = 0u;
#pragma unroll
    for (int d0 = 0; d0 < 4; ++d0) qf[d0] = *(const bf16x8_t*)(P.qb + (size_t)(m0 + tl) * 1024 + h * 64 + 16 * d0 + 8 * hi);
    const float g0 = P.ngs[(size_t)(m0 + tl) * 48 + h];
    {
        const bf16_t* ksrc = P.kcb + ((size_t)b * 64 * 4 + g) * 64; const bf16_t* vsrc = P.vcb + ((size_t)b * 64 * 4 + g) * 64;
        st_k16(L + A_K0, ld_k16(ksrc, 256, wave, lane), wave, lane); st_v16(L + A_V0, ld_v16(vsrc, 256, tid), tid);
        __syncthreads();
        qk_tile(s0, s1, L + A_K0, qf, r32, hi);
#pragma unroll
        for (int r = 0; r < 16; ++r) { const int i0 = crow(r, hi); const int d0 = t - 32 * i0 - 31, d1 = d0 - 1024;
            s0[r] = (d0 >= 0) ? s0[r] + BT[hh * 128 + (d0 > 127 ? 127 : d0)] : NEG;
            s1[r] = (d1 >= 0) ? s1[r] + BT[hh * 128 + (d1 > 127 ? 127 : d1)] : NEG; }
        float m_run = NEG, l_run = 0.f;
#pragma unroll
        for (int r = 0; r < 16; ++r) { o[0][r] = 0.f; o[1][r] = 0.f; }
        softmax_pv(s0, s1, m_run, l_run, o, L + A_V0, lane);
        const float inv = l_run > 0.f ? 1.0f / l_run : 0.f;
#pragma unroll
        for (int r = 0; r < 16; r += 2) { const int sb = crow(r, hi) >> 1;
            IMP[(hh * 64 + tl) * 32 + sb] = (s0[r] + s0[r + 1]) * inv; IMP[(hh * 64 + tl) * 32 + 16 + sb] = (s1[r] + s1[r + 1]) * inv; }
        const float sc = g0 * inv;
#pragma unroll
        for (int r = 0; r < 16; ++r) { oacc[0][r] = o[0][r] * sc; oacc[1][r] = o[1][r] * sc; }
    }
    __syncthreads();
    {
        const int tk = tid >> 3, sub = tid & 7; unsigned bits = 0u;
        if (qb + 1 <= 16) { bits = (sub == 0) ? ((1u << (qb + 1)) - 1u) : 0u; }
        else {
            float imp[32];
#pragma unroll
            for (int j = 0; j < 32; ++j) imp[j] = IMP[(0 * 64 + tk) * 32 + j] + IMP[(1 * 64 + tk) * 32 + j] + IMP[(2 * 64 + tk) * 32 + j] + IMP[(3 * 64 + tk) * 32 + j];
#pragma unroll
            for (int q4 = 0; q4 < 4; ++q4) {
                float mine = 0.f;
#pragma unroll
                for (int j = 0; j < 32; ++j) mine = (j == (sub * 4 + q4)) ? imp[j] : mine;
                const int sb = sub * 4 + q4;
                const bool forced = (sb == 0) || (sb == qb) || (sb == qb - 1); const bool cand = (sb >= 1) && (sb <= qb - 2);
                int rank = 0;
#pragma unroll
                for (int j = 1; j < 32; ++j) rank += (j <= qb - 2 && (imp[j] > mine || (imp[j] == mine && j < sb))) ? 1 : 0;
                if (forced || (cand && rank < 13)) bits |= 1u << sb;
            }
        }
        bits |= __shfl_xor(bits, 1); bits |= __shfl_xor(bits, 2); bits |= __shfl_xor(bits, 4);
        if (sub == 0) { SEL[tk] = bits; __hip_atomic_fetch_or(UNI, bits, __ATOMIC_RELAXED, __HIP_MEMORY_SCOPE_WORKGROUP); }
    }
    }
    __syncthreads();
    int tid = tid_in; asm volatile("" : "+v"(tid));
    const int lane = tid & 63, r32 = lane & 31, hi = lane >> 5, tl = 32 * th + r32;
    LAS float* BT = (LAS float*)(L + A_BT); LAS unsigned* SEL = (LAS unsigned*)(L + A_SEL); LAS unsigned* UNI = (LAS unsigned*)(L + A_UNION);
    const float NEG = -INFINITY;
    unsigned rem = UNI[0]; const unsigned selbits = SEL[tl];
    int wj = qb - (qb < 8 ? qb : 8);
    const bf16_t* ksel = P.kvb + ((size_t)0 * M + (size_t)b * TP) * 256 + g * 64; const bf16_t* vsel = P.kvb + ((size_t)1 * M + (size_t)b * TP) * 256 + g * 64;
    const bf16_t* kwin = P.kvb + ((size_t)2 * M + (size_t)b * TP) * 256 + g * 64; const bf16_t* vwin = P.kvb + ((size_t)3 * M + (size_t)b * TP) * 256 + g * 64;
    int ckind, cj, nkind, nj;
    { ckind = 0; cj = __builtin_ctz(rem); rem &= rem - 1u; }
    st_k16(L + A_K0, ld_k16(ksel + (size_t)cj * 64 * 256, 256, wave, lane), wave, lane); st_v16(L + A_V0, ld_v16(vsel + (size_t)cj * 64 * 256, 256, tid), tid);
#define PA_POP(K_, J_) { if (rem) { K_ = 0; J_ = __builtin_ctz(rem); rem &= rem - 1u; } else if (wj <= qb) { K_ = 1; J_ = wj; ++wj; } else { K_ = -1; J_ = 0; } }
#define PA_LOAD(KR_, VR_, K_, J_) { if ((K_) >= 0) { KR_ = ld_k16(((K_) ? kwin : ksel) + (size_t)(J_) * 64 * 256, 256, wave, lane); VR_ = ld_v16(((K_) ? vwin : vsel) + (size_t)(J_) * 64 * 256, 256, tid); } }
    int n2kind, n2j;
    PA_POP(nkind, nj)
    v4u kreg = {0u, 0u, 0u, 0u}, vreg = {0u, 0u, 0u, 0u};
    PA_LOAD(kreg, vreg, nkind, nj)
    __syncthreads();
    float m_run = NEG, l_run = 0.f;
#pragma unroll
    for (int r = 0; r < 16; ++r) { o[0][r] = 0.f; o[1][r] = 0.f; }
    int buf = 0;
    for (;;) {
        PA_POP(n2kind, n2j)
        v4u kreg2 = {0u, 0u, 0u, 0u}, vreg2 = {0u, 0u, 0u, 0u};
        PA_LOAD(kreg2, vreg2, n2kind, n2j)
        const LAS unsigned char* kb = L + (buf ? A_K1 : A_K0); const LAS unsigned char* vb = L + (buf ? A_V1 : A_V0);
        const int dj = qb - cj;
        const int dbase = 64 * dj + tl;
        qk_tile(s0, s1, kb, qf, r32, hi);
        const float tbias = (ckind == 0 && ((selbits >> cj) & 1u) == 0u) ? NEG : (dj <= 2 ? 0.f : BT[hh * 128 + 127]);
        if (dj <= 2) {
            const int y0 = 191 - dbase + 4 * hi, a = y0 & 3;
            const LAS f32x4_t* rb = (const LAS f32x4_t*)(L + A_RB) + (((hh * 4 + a) * 256 + (y0 - a)) >> 2);
#pragma unroll
            for (int gq = 0; gq < 4; ++gq) { const f32x4_t b0 = rb[2 * gq], b1 = rb[2 * gq + 8];
#pragma unroll
                for (int j = 0; j < 4; ++j) { s0[4 * gq + j] += b0[j]; s1[4 * gq + j] += b1[j]; } }
        } else {
            if (ckind == 1 && dj == 8) {
#pragma unroll
                for (int r = 0; r < 16; ++r) { const int k0 = crow(r, hi); const int d0 = dbase - k0, d1 = d0 - 32; if (d0 > 512) s0[r] = NEG; if (d1 > 512) s1[r] = NEG; }
            }
        }
        softmax_pv(s0, s1, m_run, l_run, o, vb, lane, tbias);
        if (nkind >= 0) { st_k16(L + (buf ? A_K0 : A_K1), kreg, wave, lane); st_v16(L + (buf ? A_V0 : A_V1), vreg, tid); }
        __syncthreads();
        if (ckind == 0 && nkind != 0) {
            const float sc = P.ngs[(size_t)(m0 + tl) * 48 + 16 + h] * (l_run > 0.f ? 1.0f / l_run : 0.f);
#pragma unroll
            for (int r = 0; r < 16; ++r) { oacc[0][r] += o[0][r] * sc; oacc[1][r] += o[1][r] * sc; o[0][r] = 0.f; o[1][r] = 0.f; }
            m_run = NEG; l_run = 0.f;
        }
        if (nkind < 0) break;
        ckind = nkind; cj = nj; nkind = n2kind; nj = n2j; kreg = kreg2; vreg = vreg2; buf ^= 1;
    }
#undef PA_POP
#undef PA_LOAD
    {
        const float sc = P.ngs[(size_t)(m0 + tl) * 48 + 32 + h] * (l_run > 0.f ? 1.0f / l_run : 0.f);
#pragma unroll
        for (int r = 0; r < 16; ++r) { oacc[0][r] += o[0][r] * sc; oacc[1][r] += o[1][r] * sc; }
    }
    bf16_t* orow = P.xcat + (size_t)(m0 + tl) * D + 1024 + h * 64;
#pragma unroll
    for (int dd = 0; dd < 2; ++dd)
#pragma unroll
        for (int gq = 0; gq < 4; ++gq) { uint2 w; w.x = cvtpk(oacc[dd][4 * gq], oacc[dd][4 * gq + 1]); w.y = cvtpk(oacc[dd][4 * gq + 2], oacc[dd][4 * gq + 3]);
            *(uint2*)(orow + 32 * dd + 8 * gq + 4 * hi) = w; }
}
__device__ __forceinline__ void attn_prompt_stage(const Ptrs& P, LAS unsigned char* L, int bid, int nblk, int tid) {
    for (int pi = bid; pi < 256; pi += nblk) {
        const int bg = pi >> 4, s = pi & 15;
        for (int u = 0; u < 2; ++u) attn_prompt_unit(P, L, bg >> 2, bg & 3, u ? 31 - s : s, tid, u == 0);
    }
}

constexpr int S_BT = 131072 + 1024, S_IMP = S_BT + 2048, S_PC = 131072 + 8192, S_Q = S_PC + 4096;
__device__ __forceinline__ v4u pack8(const float4 a, const float4 b) { v4u t; t.x = pk2(a.x, a.y); t.y = pk2(a.z, a.w); t.z = pk2(b.x, b.y); t.w = pk2(b.z, b.w); return t; }
struct Rows16 { float4 r[16]; };
__device__ __forceinline__ void rows_load(Rows16& T, const float* base, int stride, int nvalid, int lane) {
    const float* p = base + (size_t)(lane >> 4) * stride + 4 * (lane & 15); const size_t inc = (size_t)4 * stride; (void)nvalid;
#pragma unroll
    for (int i = 0; i < 16; ++i) { T.r[i] = *(const float4*)p; p += inc; }
}
__device__ __forceinline__ void rows_store(const Rows16& T, float* dst, bool first, int lane) {
    float* p = dst + (size_t)(lane >> 4) * 512 + 4 * (lane & 15);
    if (!first) *(float4*)p = T.r[0];
#pragma unroll
    for (int i = 1; i < 16; ++i) *(float4*)(p + (size_t)i * 2048) = T.r[i];
}
typedef unsigned v2u __attribute__((ext_vector_type(2)));
__device__ __forceinline__ v2u pack4(const float4 a) { v2u t; t.x = pk2(a.x, a.y); t.y = pk2(a.z, a.w); return t; }
__device__ __forceinline__ void rows_stage_k(LAS unsigned char* kb, const Rows16& T, int nvalid, int lane) {
    const int q = lane >> 4, dc = lane & 15, c = dc >> 1, p = dc & 1; const bool part = nvalid < 64;
    LAS unsigned char* be = kb + c * 1024 + ((q ^ c) * 16) + p * 8;
    LAS unsigned char* bo = kb + c * 1024 + (((q ^ c) ^ 4) * 16) + p * 8;
#pragma unroll
    for (int i = 0; i < 16; ++i) { float4 a = T.r[i]; if (i > 0 && part) a = make_float4(0.f, 0.f, 0.f, 0.f);
        *(LAS v2u*)(((i & 1) ? bo : be) + 128 * (i >> 1)) = pack4(a); }
}
__device__ __forceinline__ void rows_stage_v(LAS unsigned char* vb, const Rows16& T, int nvalid, int lane) {
    const int q = lane >> 4, dc = lane & 15; const bool part = nvalid < 64;
    LAS unsigned char* b0 = vb + (dc >> 3) * 4096 + q * 64 + (dc & 7) * 8;
#pragma unroll
    for (int i = 0; i < 16; ++i) { float4 a = T.r[i]; if (i > 0 && part) a = make_float4(0.f, 0.f, 0.f, 0.f);
        *(LAS v2u*)(b0 + (i >> 1) * 512 + (i & 1) * 256) = pack4(a); }
}
__device__ __forceinline__ void attn_sample_unit(const Ptrs& P, LAS unsigned char* L, int b, int g, int tid) {
    const int lane = tid & 63, wave = __builtin_amdgcn_readfirstlane(tid >> 6), r32 = lane & 31, hi = lane >> 5, q = r32 & 15, tok = q >> 2, hh = q & 3, h = g * 4 + hh;
    LAS float* BT = (LAS float*)(L + S_BT); LAS float* IMP = (LAS float*)(L + S_IMP + wave * 512);
    LAS unsigned char* KB = L + wave * 16384; LAS unsigned char* VB = KB + 8192;
    const float NEG = -INFINITY; const int mrow = MP + b * TS + tok;
    __syncthreads();
    BT[tid] = P.rel_bias[BUCKET[tid & 127] * 16 + g * 4 + (tid >> 7)] * LOG2E;
    bf16x8_t qf[4];
#pragma unroll
    for (int d0 = 0; d0 < 4; ++d0) qf[d0] = *(const bf16x8_t*)(P.qb + (size_t)mrow * 1024 + h * 64 + 16 * d0 + 8 * hi);
    { const bf16_t* ksrc = P.kcb + ((size_t)((BP + b) * 64 + lane) * 4 + g) * 64; const bf16_t* vsrc = P.vcb + ((size_t)((BP + b) * 64 + lane) * 4 + g) * 64;
#pragma unroll
      for (int c = 0; c < 8; ++c) { *(LAS v4u*)(KB + c * 1024 + ((lane ^ c) * 16)) = *(const v4u*)(ksrc + 8 * c);
          *(LAS v4u*)(VB + (c >> 2) * 4096 + (lane >> 3) * 512 + (lane & 7) * 64 + (c & 3) * 16) = *(const v4u*)(vsrc + 8 * c); } }
    if (wave == 0) {
#pragma unroll
        for (int d0 = 0; d0 < 4; ++d0) *(LAS bf16x8_t*)(L + S_Q + ((d0 * 2 + hi) * 32 + r32) * 16) = qf[d0]; }
    __syncthreads();
    f32x16_t s0, s1, o[2];
    float m_run = NEG, l_run = 0.f;
#pragma unroll
    for (int r = 0; r < 16; ++r) { o[0][r] = 0.f; o[1][r] = 0.f; }
    unsigned selbits = 0u, uni = 0u;
    if (wave < 6) {
    qk_tile(s0, s1, KB, qf, r32, hi);
#pragma unroll
    for (int r = 0; r < 16; ++r) { const int i0 = crow(r, hi); const int d0 = PAST + tok - 32 * i0 - 31, d1 = d0 - 1024;
        s0[r] += BT[hh * 128 + (d0 > 127 ? 127 : d0)]; s1[r] += BT[hh * 128 + (d1 > 127 ? 127 : d1)]; }
    softmax_pv(s0, s1, m_run, l_run, o, VB, lane);
    const float inv = 1.0f / l_run;
#pragma unroll
    for (int r = 0; r < 16; r += 2) { float a = (s0[r] + s0[r + 1]) * inv, c = (s1[r] + s1[r + 1]) * inv;
        a += __shfl_xor(a, 1); a += __shfl_xor(a, 2); c += __shfl_xor(c, 1); c += __shfl_xor(c, 2);
        if (hh == 0 && r32 < 16) { const int sb = crow(r, hi) >> 1; IMP[tok * 32 + sb] = a; IMP[tok * 32 + 16 + sb] = c; } }
    if (wave == 0 && r32 < 16) { LAS float* PC = (LAS float*)(L + S_PC) + q * 64;
#pragma unroll
        for (int dd = 0; dd < 2; ++dd)
#pragma unroll
            for (int r = 0; r < 16; ++r) PC[32 * dd + crow(r, hi)] = o[dd][r] * inv; }
    asm volatile("s_waitcnt lgkmcnt(0)" ::: "memory");
    { const int tk = lane >> 4, sp = lane & 15; unsigned bits = 0u;
      float imp[32];
#pragma unroll
      for (int q4 = 0; q4 < 8; ++q4) { const f32x4_t v = *(const LAS f32x4_t*)(IMP + tk * 32 + 4 * q4); imp[4 * q4] = v[0]; imp[4 * q4 + 1] = v[1]; imp[4 * q4 + 2] = v[2]; imp[4 * q4 + 3] = v[3]; }
#pragma unroll
      for (int i = 0; i < 2; ++i) { const int sb = 2 * sp + i; const float mine = IMP[tk * 32 + sb]; int rank = 0;
#pragma unroll
          for (int j = 1; j <= 30; ++j) { const float v = imp[j]; rank += (v > mine || (v == mine && j < sb)) ? 1 : 0; }
          const bool forced = (sb == 0) || (sb == 31); const bool cand = (sb >= 1) && (sb <= 30);
          if (forced || (cand && rank < 13)) bits |= 1u << sb; }
      bits |= __shfl_xor(bits, 1); bits |= __shfl_xor(bits, 2); bits |= __shfl_xor(bits, 4); bits |= __shfl_xor(bits, 8);
      selbits = __shfl(bits, tok * 16);
      uni = (unsigned)(__builtin_amdgcn_readlane((int)bits, 0) | __builtin_amdgcn_readlane((int)bits, 16) | __builtin_amdgcn_readlane((int)bits, 32) | __builtin_amdgcn_readlane((int)bits, 48)); }
    }
    m_run = NEG; l_run = 0.f;
#pragma unroll
    for (int r = 0; r < 16; ++r) { o[0][r] = 0.f; o[1][r] = 0.f; }
    const bool is_sel = wave < 6; const int first = is_sel ? wave : wave - 6, step = is_sel ? 6 : 2;
    unsigned long long rem = is_sel ? ((unsigned long long)uni | (1ull << 32)) : 0x1FFull;
    for (int k = 0; k < first; ++k) rem &= rem - 1ull;
#define TILE_POP(J_) { if (rem) { J_ = __builtin_ctzll(rem); for (int k_ = 0; k_ < step; ++k_) rem &= rem - 1ull; } else J_ = -1; }
#define SRC_TILE(jj, KB_, ST_, NV_) { const bool nk_ = is_sel ? ((jj) == 32) : ((jj) == 8); \
        if (nk_) { NV_ = TS; if (is_sel) { KB_ = P.out + O_KVS + (size_t)(b * TS) * 1024 + 512 + g * 64; ST_ = 1024; } else { KB_ = P.out + O_WINS + ((size_t)(b * 512 + 508) * 2) * 256 + g * 64; ST_ = 512; } } \
        else if (is_sel) { const int pos0 = 64 * (jj); const int page = P.pt[b * 16 + (pos0 >> 7)]; KB_ = P.cache + (((size_t)page * 128 + (pos0 & 127)) * 4 + 2) * 256 + g * 64; ST_ = 1024; NV_ = 64; } \
        else { KB_ = P.swin + ((size_t)(b * 512 + 64 * (jj)) * 2) * 256 + g * 64; ST_ = 512; NV_ = 64; } }
    Rows16 KR, VR;
    int j; TILE_POP(j);
    if (j >= 0) { const float* kb0; int st0, nv0; SRC_TILE(j, kb0, st0, nv0); rows_load(KR, kb0, st0, nv0, lane); }
    while (j >= 0) {
        int jnext; TILE_POP(jnext);
        const float* kbc; int stc, nvc; SRC_TILE(j, kbc, stc, nvc);
        rows_stage_k(KB, KR, nvc, lane);
        const bool wcopy = !is_sel && j < 8; float* wdst = P.out + O_WINS + ((size_t)(b * 512 + 64 * j) - 4) * 512 + g * 64;
        if (wcopy) rows_store(KR, wdst, j == 0, lane);
        rows_load(VR, kbc + 256, stc, nvc, lane);
        bf16x8_t qt[4];
#pragma unroll
        for (int d0 = 0; d0 < 4; ++d0) qt[d0] = *(const LAS bf16x8_t*)(L + S_Q + ((d0 * 2 + hi) * 32 + r32) * 16);
        asm volatile("s_waitcnt lgkmcnt(0)" ::: "memory");
        const int tb = is_sel ? (PAST - 64 * j) : (512 - 64 * j);
        const int dbase = tb + tok;
        qk_tile(s0, s1, KB, qt, r32, hi);
        const float tbias = (is_sel && j < 32 && ((selbits >> j) & 1u) == 0u) ? NEG : (tb <= 128 ? 0.f : BT[hh * 128 + 127]);
        if (tb <= 128) {
#pragma unroll
            for (int r = 0; r < 16; ++r) { const int k0 = crow(r, hi); const int d0 = dbase - k0, d1 = d0 - 32;
                const float b0 = BT[hh * 128 + (d0 > 127 ? 127 : (d0 < 0 ? 0 : d0))], b1 = BT[hh * 128 + (d1 > 127 ? 127 : (d1 < 0 ? 0 : d1))];
                s0[r] = (d0 >= 0) ? s0[r] + b0 : NEG; s1[r] = (d1 >= 0) ? s1[r] + b1 : NEG; }
        } else {
            if (!is_sel && tb == 512) {
#pragma unroll
                for (int r = 0; r < 16; ++r) { const int k0 = crow(r, hi); const int d0 = dbase - k0, d1 = d0 - 32; if (d0 > 512) s0[r] = NEG; if (d1 > 512) s1[r] = NEG; }
            }
        }
        rows_stage_v(VB, VR, nvc, lane);
        if (wcopy) rows_store(VR, wdst + 256, j == 0, lane);
        asm volatile("" ::: "memory");
        { const int jn = (jnext >= 0) ? jnext : j; const float* kbn; int stn, nvn; SRC_TILE(jn, kbn, stn, nvn); rows_load(KR, kbn, stn, nvn, lane); }
        asm volatile("s_waitcnt lgkmcnt(0)" ::: "memory");
        softmax_pv(s0, s1, m_run, l_run, o, VB, lane, tbias);
        asm volatile("s_waitcnt lgkmcnt(0)" ::: "memory");
        j = jnext;
    }
#undef SRC_TILE
#undef TILE_POP
    int l2; asm volatile("v_mbcnt_lo_u32_b32 %0, -1, 0\n\tv_mbcnt_hi_u32_b32 %0, -1, %0" : "=v"(l2));
    if ((l2 & 31) < 16) {
        const int q2 = l2 & 15, hi2 = l2 >> 5;
        LAS float* PO = (LAS float*)KB + q2 * 64;
#pragma unroll
        for (int dd = 0; dd < 2; ++dd)
#pragma unroll
            for (int r = 0; r < 16; ++r) PO[32 * dd + crow(r, hi2)] = o[dd][r];
        if (hi2 == 0) { LAS float* PM = (LAS float*)(KB + 4096); PM[2 * q2] = m_run; PM[2 * q2 + 1] = l_run; }
    }
    __syncthreads();
    {
        const int tid2 = wave * 64 + l2;
        const int cq = tid2 >> 5, cd = 2 * (tid2 & 31), ct = cq >> 2, ch = g * 4 + (cq & 3);
        float msel = NEG, mwin = NEG;
#pragma unroll
        for (int w = 0; w < 8; ++w) { const float mw = ((LAS float*)(L + w * 16384 + 4096))[2 * cq]; if (w < 6) msel = fmaxf(msel, mw); else mwin = fmaxf(mwin, mw); }
        float lsel = 0.f, lwin = 0.f, os0 = 0.f, os1 = 0.f, ow0 = 0.f, ow1 = 0.f;
#pragma unroll
        for (int w = 0; w < 8; ++w) { const LAS float* PM = (LAS float*)(L + w * 16384 + 4096); const LAS float* PO = (LAS float*)(L + w * 16384) + cq * 64 + cd;
            const float mw = PM[2 * cq], lw = PM[2 * cq + 1]; const float f = __builtin_amdgcn_exp2f(mw - (w < 6 ? msel : mwin));
            if (w < 6) { lsel += lw * f; os0 += PO[0] * f; os1 += PO[1] * f; } else { lwin += lw * f; ow0 += PO[0] * f; ow1 += PO[1] * f; } }
        const LAS float* PC = (LAS float*)(L + S_PC) + cq * 64 + cd;
        const size_t mr = (size_t)(MP + b * TS + ct);
        const float g0 = P.ngs[mr * 48 + ch], g1 = P.ngs[mr * 48 + 16 + ch], g2 = P.ngs[mr * 48 + 32 + ch];
        const float is = g1 / lsel, iw = g2 / lwin;
        const float r0 = g0 * PC[0] + os0 * is + ow0 * iw, r1 = g0 * PC[1] + os1 * is + ow1 * iw;
        *(unsigned*)(P.xcat + mr * D + 1024 + ch * 64 + cd) = pk2(r0, r1);
    }
}
__device__ __forceinline__ void attn_sample_stage(const Ptrs& P, LAS unsigned char* L, int bid, int nblk, int tid) {
    for (int u = bid; u < BS * 4; u += nblk) attn_sample_unit(P, L, u >> 2, u & 3, tid);
}

__device__ __forceinline__ float fsig(float x) { return __builtin_amdgcn_rcpf(1.0f + __builtin_amdgcn_exp2f(-x * 1.4426950408889634f)); }
__device__ __forceinline__ float bflo(unsigned u) { return __builtin_bit_cast(float, u << 16); }
__device__ __forceinline__ float bfhi(unsigned u) { return __builtin_bit_cast(float, u & 0xffff0000u); }
struct EpiIn {
    static constexpr bool PERM = true, AFTER_DRAIN = false, HAS_MID = false;
    float* out; float* poolin; bf16_t* qb; bf16_t* kvb; bf16_t* gateb;
    __device__ __forceinline__ void operator()(const pg8::f32x4 (&acc)[2][2][4][2], const pg8::Unit& u, int wr, int wc, int fr, int fq) const {
        const int pn = u.pn, pm = u.pm;
#pragma unroll
        for (int ai = 0; ai < 2; ++ai)
#pragma unroll
            for (int m = 0; m < 4; ++m) {
                const int row = pm * 256 + ai * 128 + wr * 64 + m * 16 + fr;
#pragma unroll
                for (int bj = 0; bj < 2; ++bj) {
                    const int cc = bj * 128 + wc * 32 + 8 * fq; const pg8::f32x4 v0 = acc[ai][bj][m][0], v1 = acc[ai][bj][m][1];
                    if (pn < 4) { float* p = poolin + (size_t)row * PW + pn * 256 + cc; *(pg8::f32x4*)p = v0; *(pg8::f32x4*)(p + 4) = v1; }
                    else if (pn < 8) { v4u w; w.x = pk2(v0[0] * QSCALE, v0[1] * QSCALE); w.y = pk2(v0[2] * QSCALE, v0[3] * QSCALE); w.z = pk2(v1[0] * QSCALE, v1[1] * QSCALE); w.w = pk2(v1[2] * QSCALE, v1[3] * QSCALE);
                        *(v4u*)(qb + (size_t)row * 1024 + (pn - 4) * 256 + cc) = w; }
                    else if (pn < 14) { const int slot = pn - 8; float* dst = nullptr;
                        if (slot < 4) dst = (pm < 32) ? out + O_KVP + (size_t)row * 1024 + slot * 256 + cc : out + O_KVS + (size_t)(row - MP) * 1024 + slot * 256 + cc;
                        else if (pm >= 32) { const int r = row - MP; dst = out + O_WINS + ((size_t)((r >> 2) * 512 + 508 + (r & 3)) * 2 + (slot - 4)) * 256 + cc; }
                        else if ((pm & 7) >= 6) dst = out + O_WINP + ((size_t)((row >> 11) * 512 + (row & 2047) - 1536) * 2 + (slot - 4)) * 256 + cc;
                        if (dst) { *(pg8::f32x4*)dst = v0; *(pg8::f32x4*)(dst + 4) = v1; }
                        if (slot >= 2) { v4u w; w.x = pk2(v0[0], v0[1]); w.y = pk2(v0[2], v0[3]); w.z = pk2(v1[0], v1[1]); w.w = pk2(v1[2], v1[3]); *(v4u*)(kvb + ((size_t)(slot - 2) * M + row) * 256 + cc) = w; } }
                    else { v4u w; w.x = pk2(fsig(v0[0]), fsig(v0[1])); w.y = pk2(fsig(v0[2]), fsig(v0[3])); w.z = pk2(fsig(v1[0]), fsig(v1[1])); w.w = pk2(fsig(v1[2]), fsig(v1[3]));
                        *(v4u*)(gateb + (size_t)row * 4096 + (pn - 14) * 256 + cc) = w; }
                }
            }
    }
};
struct EpiB16 {
    static constexpr bool PERM = true, AFTER_DRAIN = false, HAS_MID = false;
    bf16_t* C; int ldc;
    __device__ __forceinline__ void operator()(const pg8::f32x4 (&acc)[2][2][4][2], const pg8::Unit& u, int wr, int wc, int fr, int fq) const {
#pragma unroll
        for (int ai = 0; ai < 2; ++ai)
#pragma unroll
            for (int m = 0; m < 4; ++m) { const int row = u.pm * 256 + ai * 128 + wr * 64 + m * 16 + fr;
#pragma unroll
                for (int bj = 0; bj < 2; ++bj) { const int col = u.pn * 256 + bj * 128 + wc * 32 + 8 * fq; const pg8::f32x4 v0 = acc[ai][bj][m][0], v1 = acc[ai][bj][m][1];
                    v4u w; w.x = pk2(v0[0], v0[1]); w.y = pk2(v0[2], v0[3]); w.z = pk2(v1[0], v1[1]); w.w = pk2(v1[2], v1[3]); *(v4u*)(C + (size_t)row * ldc + col) = w; } }
    }
};
struct EpiMerge {
    static constexpr bool PERM = true, AFTER_DRAIN = false, HAS_MID = true;
    const bf16_t* gateb; bf16_t* mergedb;
    __device__ __forceinline__ void mid(pg8::f32x4 (&acc)[2][2][4][2], const pg8::Unit& u, int wr, int wc, int fr, int fq) const {
        const bf16_t* gp = gateb + (size_t)(u.pm * 256) * 4096 + u.pn * 256; asm volatile("" : "+s"(gp));
        unsigned lo = (unsigned)((wr * 64 + fr) * 4096 + wc * 32 + 8 * fq); asm volatile("" : "+v"(lo));
#pragma unroll
        for (int ai = 0; ai < 2; ++ai)
#pragma unroll
            for (int m = 0; m < 4; ++m) {
#pragma unroll
                for (int bj = 0; bj < 2; ++bj) { const unsigned off = lo + (unsigned)((ai * 128 + m * 16) * 4096 + bj * 128);
                    const v4u ga = *(const v4u*)(gp + off), gb = *(const v4u*)(gp + off + 2048);
                    const unsigned gaw[4] = {ga.x, ga.y, ga.z, ga.w}, gbw[4] = {gb.x, gb.y, gb.z, gb.w};
#pragma unroll
                    for (int k = 0; k < 4; ++k) { const float r0 = bflo(gaw[k]) * __builtin_amdgcn_rcpf(fmaxf(bflo(gbw[k]), 1e-30f)), r1 = bfhi(gaw[k]) * __builtin_amdgcn_rcpf(fmaxf(bfhi(gbw[k]), 1e-30f));
                        acc[ai][bj][m][k >> 1][(k & 1) * 2] *= r0; acc[ai][bj][m][k >> 1][(k & 1) * 2 + 1] *= r1; } }
                asm volatile("" : "+v"(acc[ai][0][m][0]), "+v"(acc[ai][0][m][1]), "+v"(acc[ai][1][m][0]), "+v"(acc[ai][1][m][1]) :: "memory"); }
    }
    __device__ __forceinline__ void operator()(const pg8::f32x4 (&acc)[2][2][4][2], const pg8::Unit& u, int wr, int wc, int fr, int fq) const {
#pragma unroll
        for (int ai = 0; ai < 2; ++ai)
#pragma unroll
            for (int m = 0; m < 4; ++m) { const int row = u.pm * 256 + ai * 128 + wr * 64 + m * 16 + fr;
#pragma unroll
                for (int bj = 0; bj < 2; ++bj) { const int col = u.pn * 256 + bj * 128 + wc * 32 + 8 * fq;
                    const v4u gb = *(const v4u*)(gateb + (size_t)row * 4096 + 2048 + col); const unsigned gbw[4] = {gb.x, gb.y, gb.z, gb.w}; unsigned w[4];
#pragma unroll
                    for (int k = 0; k < 4; ++k) w[k] = pk2(acc[ai][bj][m][k >> 1][(k & 1) * 2] * fmaxf(bflo(gbw[k]), 1e-30f), acc[ai][bj][m][k >> 1][(k & 1) * 2 + 1] * fmaxf(bfhi(gbw[k]), 1e-30f));
                    v4u o; o.x = w[0]; o.y = w[1]; o.z = w[2]; o.w = w[3]; *(v4u*)(mergedb + (size_t)row * D + col) = o; }
                asm volatile("" ::: "memory"); }
    }
};
#define DPP_F(oldv, src, ctrl) __builtin_bit_cast(float, __builtin_amdgcn_update_dpp(__builtin_bit_cast(int, (float)(oldv)), __builtin_bit_cast(int, (float)(src)), (ctrl), 0xf, 0xf, false))
struct EpiUpAct {
    static constexpr bool PERM = true, AFTER_DRAIN = false, HAS_MID = false;
    bf16_t* actb; float* out; float* ws; const float* conv_w; const float* conv_b;
    __device__ __forceinline__ void operator()(const pg8::f32x4 (&acc)[2][2][4][2], const pg8::Unit& u, int wr, int wc, int fr, int fq) const {
        const int pn = u.pn, pm = u.pm; const bool smp = pm >= 32;
        const int f = pn * 128 + wc * 32 + 8 * fq;
        float cw0[8], cw1[8], cw2[8], cb[8];
        { const F8 a = ld8f(conv_w + f), b = ld8f(conv_w + FF + f), c = ld8f(conv_w + 2 * FF + f), d = ld8f(conv_b + f);
#pragma unroll
          for (int e = 0; e < 8; ++e) { cw0[e] = a.v[e]; cw1[e] = b.v[e]; cw2[e] = c.v[e]; cb[e] = d.v[e]; } }
#pragma unroll
        for (int ai = 0; ai < 2; ++ai)
#pragma unroll
            for (int m = 0; m < 4; ++m) {
                const int row = pm * 256 + ai * 128 + wr * 64 + m * 16 + fr;
                float o[8], gq[8], vq[8];
#pragma unroll
                for (int e = 0; e < 8; ++e) {
                    const float g = acc[ai][1][m][e >> 2][e & 3], gp = (m > 0) ? acc[ai][1][m > 0 ? m - 1 : 0][e >> 2][e & 3] : g, v = acc[ai][0][m][e >> 2][e & 3];
                    const float p1 = DPP_F(DPP_F(0.f, gp, 0x121), g, 0x111);
                    const float p2 = DPP_F(DPP_F(0.f, gp, 0x122), g, 0x112);
                    o[e] = gelu_tanh(cb[e] + cw0[e] * p2 + cw1[e] * p1 + cw2[e] * g) * v; gq[e] = g; vq[e] = v; }
                { v4u w; w.x = pk2(o[0], o[1]); w.y = pk2(o[2], o[3]); w.z = pk2(o[4], o[5]); w.w = pk2(o[6], o[7]); *(v4u*)(actb + (size_t)row * FF + f) = w; }
                if (smp) { const int r = row - MP, t = r & 3;
                    if (t < 2) { const size_t fid = 256 + (size_t)(r >> 2) * 2 + t; F8 a, b;
#pragma unroll
                        for (int e = 0; e < 8; ++e) { a.v[e] = vq[e]; b.v[e] = gq[e]; }
                        st8f(ws + W_FIXV + fid * FF + f, a); st8f(ws + W_FIXG + fid * FF + f, b); }
                    else { F8 b;
#pragma unroll
                        for (int e = 0; e < 8; ++e) b.v[e] = gq[e];
                        st8f(out + O_CONVS + ((size_t)(r >> 2) * 2 + (t - 2)) * FF + f, b); } }
                else {
                    if (m == 0 && fr < 2) { const size_t fid = (size_t)(row >> 6) * 2 + fr; F8 a, b;
#pragma unroll
                        for (int e = 0; e < 8; ++e) { a.v[e] = vq[e]; b.v[e] = gq[e]; }
                        st8f(ws + W_FIXV + fid * FF + f, a); st8f(ws + W_FIXG + fid * FF + f, b); }
                    if (m == 3 && fr >= 14) { F8 b;
#pragma unroll
                        for (int e = 0; e < 8; ++e) b.v[e] = gq[e];
                        st8f(ws + W_TAILG + ((size_t)(row >> 6) * 2 + (fr - 14)) * FF + f, b);
                        if ((row & 2047) >= 2046) st8f(out + O_CONVP + ((size_t)(row >> 11) * 2 + ((row & 2047) - 2046)) * FF + f, b); } }
            }
    }
};
__device__ __forceinline__ void act_fix_stage(const Ptrs& P, size_t gtid, size_t nthr) {
    const float* FV = P.ws + W_FIXV; const float* FG = P.ws + W_FIXG; const float* TG = P.ws + W_TAILG;
    for (size_t i = gtid; i < (size_t)512 * (FF / 8); i += nthr) { const int fid = (int)(i / (FF / 8)), f = (int)(i % (FF / 8)) * 8;
        F8 g1, g2; int row;
#pragma unroll
        for (int e = 0; e < 8; ++e) { g1.v[e] = 0.f; g2.v[e] = 0.f; }
        if (fid < 256) { const int blk = fid >> 1, ii = fid & 1; row = blk * 64 + ii; const int t = row & 2047;
            if (ii == 0) { if (t != 0) { g1 = ld8f(TG + ((size_t)(blk - 1) * 2 + 1) * FF + f); g2 = ld8f(TG + ((size_t)(blk - 1) * 2 + 0) * FF + f); } }
            else { g1 = ld8f(FG + (size_t)(fid - 1) * FF + f); if (t != 1) g2 = ld8f(TG + ((size_t)(blk - 1) * 2 + 1) * FF + f); } }
        else { const int sidx = fid - 256, b = sidx >> 1, t = sidx & 1; row = MP + b * TS + t;
            if (t == 0) { g1 = ld8f(P.sconv + ((size_t)b * 2 + 1) * FF + f); g2 = ld8f(P.sconv + ((size_t)b * 2 + 0) * FF + f); }
            else { g1 = ld8f(FG + (size_t)(fid - 1) * FF + f); g2 = ld8f(P.sconv + ((size_t)b * 2 + 1) * FF + f); } }
        const F8 g0 = ld8f(FG + (size_t)fid * FF + f), vv = ld8f(FV + (size_t)fid * FF + f), c0 = ld8f(P.conv_w + f), c1 = ld8f(P.conv_w + FF + f), c2 = ld8f(P.conv_w + 2 * FF + f), cb = ld8f(P.conv_b + f);
        F8 o;
#pragma unroll
        for (int e = 0; e < 8; ++e) o.v[e] = gelu_tanh(cb.v[e] + c0.v[e] * g2.v[e] + c1.v[e] * g1.v[e] + c2.v[e] * g0.v[e]) * vv.v[e];
        st8h(P.actb + (size_t)row * FF + f, o); }
}
__device__ __forceinline__ void merge_sample_stage(const Ptrs& P, size_t gtid, size_t nthr) {
    const bf16_t* SL = (const bf16_t*)(P.ws + W_SLABM);
    for (size_t i = gtid; i < (size_t)MS * D / 8; i += nthr) { const int r = (int)(i >> 8), c = (int)(i & 255) * 8;
        F8 a, b;
#pragma unroll
        for (int e = 0; e < 8; ++e) { a.v[e] = 0.f; b.v[e] = 0.f; }
#pragma unroll
        for (int k = 0; k < 4; ++k) { const F8 x = ld8h(SL + (size_t)k * MS * D + (size_t)r * D + c), y = ld8h(SL + (size_t)(k + 4) * MS * D + (size_t)r * D + c);
#pragma unroll
            for (int e = 0; e < 8; ++e) { a.v[e] += x.v[e]; b.v[e] += y.v[e]; } }
        const F8 ga = ld8h(P.gateb + (size_t)(MP + r) * 4096 + c), gb = ld8h(P.gateb + (size_t)(MP + r) * 4096 + 2048 + c);
        F8 o;
#pragma unroll
        for (int e = 0; e < 8; ++e) o.v[e] = ga.v[e] * a.v[e] + gb.v[e] * b.v[e];
        st8h(P.mergedb + (size_t)(MP + r) * D + c, o); }
}
__device__ __forceinline__ float4 pool_prev(const Ptrs& P, const float* PI, int m, int t, int j, bool isP, int b, int c) {
    const int tt = t - j;
    if (tt >= 0) return *(const float4*)(PI + (size_t)(m - j) * PW + c);
    if (!isP) return *(const float4*)(P.spool + ((size_t)b * 15 + 15 + tt) * 1024 + c);
    return make_float4(0.f, 0.f, 0.f, 0.f);
}
__device__ __forceinline__ void pool_stage(const Ptrs& P, size_t gtid, size_t nthr) {
    const float* PI = P.ws + W_POOLIN;
    const int nseg = (int)(nthr >> 8), seg = (int)(gtid >> 8), c = (int)(gtid & 255) * 4, w = 2 << (c >> 8);
    if (nseg > 0 && seg < nseg) {
        const int rps = (M + nseg - 1) / nseg, mb = seg * rps, me = (mb + rps < M) ? mb + rps : M;
        float4 S = make_float4(0.f, 0.f, 0.f, 0.f);
        int m = mb;
        while (m < me) {
            const bool isP = m < MP; const int b = isP ? m / TP : (m - MP) / TS, t = isP ? m % TP : (m - MP) % TS;
            if (m != mb && isP && t >= w && t + 7 < TP && m + 7 < me) {
                float4 x[8], v[8];
#pragma unroll
                for (int i = 0; i < 8; ++i) { x[i] = *(const float4*)(PI + (size_t)(m + i) * PW + c); v[i] = *(const float4*)(PI + (size_t)(m + i - w) * PW + c); }
                const float ic = 1.0f / (float)w;
#pragma unroll
                for (int i = 0; i < 8; ++i) { S.x += x[i].x - v[i].x; S.y += x[i].y - v[i].y; S.z += x[i].z - v[i].z; S.w += x[i].w - v[i].w;
                    uint2 o; o.x = pk2(S.x * ic - x[i].x, S.y * ic - x[i].y); o.y = pk2(S.z * ic - x[i].z, S.w * ic - x[i].w); *(uint2*)(P.xcat + (size_t)(m + i) * D + c) = o; }
                m += 8;
            } else {
                const float4 x = *(const float4*)(PI + (size_t)m * PW + c);
                if (m == mb || t == 0) { S = x;
#pragma unroll
                    for (int jj = 1; jj < 16; ++jj) { const int tt = t - jj; const bool inw = jj < w; const bool fromPI = inw && tt >= 0, fromS = inw && tt < 0 && !isP;
                        const float* p = fromPI ? PI + (size_t)(m - jj) * PW + c : (fromS ? P.spool + ((size_t)b * 15 + 15 + tt) * 1024 + c : PI + (size_t)m * PW + c);
                        const float4 vv = *(const float4*)p; const float sc = (fromPI || fromS) ? 1.0f : 0.0f;
                        S.x += vv.x * sc; S.y += vv.y * sc; S.z += vv.z * sc; S.w += vv.w * sc; } }
                else { const float4 v = pool_prev(P, PI, m, t, w, isP, b, c); S.x += x.x - v.x; S.y += x.y - v.y; S.z += x.z - v.z; S.w += x.w - v.w; }
                const int pos = isP ? t : PAST + t; const float ic = 1.0f / (float)((w < pos + 1) ? w : pos + 1);
                uint2 o; o.x = pk2(S.x * ic - x.x, S.y * ic - x.y); o.y = pk2(S.z * ic - x.z, S.w * ic - x.w); *(uint2*)(P.xcat + (size_t)m * D + c) = o;
                ++m;
            }
        }
    }
    for (size_t i = gtid; i < (size_t)BP * 15 * 256; i += nthr) { const int c = (int)(i & 255) * 4; const int r = (int)(i >> 8); const int b = r / 15, j = r % 15;
        *(float4*)(P.out + O_POOLP + (size_t)r * 1024 + c) = *(const float4*)(PI + (size_t)(b * TP + (TP - 15) + j) * PW + c); }
    for (size_t i = gtid; i < (size_t)BS * 4 * 256; i += nthr) { const int c = (int)(i & 255) * 4; const int r = (int)(i >> 8); const int b = r >> 2, j = r & 3;
        *(float4*)(P.out + O_POOLS + ((size_t)b * 15 + 11 + j) * 1024 + c) = *(const float4*)(PI + (size_t)(MP + b * TS + j) * PW + c); }
}
__device__ __forceinline__ void prologue_state_copies(const Ptrs& P, size_t gtid, size_t nthr) {
    for (size_t i = gtid; i < (size_t)BS * 11 * 256; i += nthr) { const int c = (int)(i & 255) * 4; const int r = (int)(i >> 8); const int b = r / 11, j = r % 11;
        *(float4*)(P.out + O_POOLS + ((size_t)b * 15 + j) * 1024 + c) = *(const float4*)(P.spool + ((size_t)b * 15 + j + 4) * 1024 + c); }
}
#define XB_TMO      128
#define XB_XCNT(j)  (256  + 64 * (j))
#define XB_XSUB(j)  (1280 + 64 * (j))
#define XB_XGEN(j)  (2304 + 64 * (j))
#define XB_TOP      3328
#define XB_TOPGEN   3392
#define XCD_BAR_WORDS 3456
#define XB_SPIN_CAP (1u << 22)

__device__ __forceinline__ unsigned xb_ld(unsigned* p)              { return __hip_atomic_load(p, __ATOMIC_RELAXED, __HIP_MEMORY_SCOPE_AGENT); }
__device__ __forceinline__ unsigned xb_add(unsigned* p, unsigned v) { return __hip_atomic_fetch_add(p, v, __ATOMIC_RELAXED, __HIP_MEMORY_SCOPE_AGENT); }
__device__ __forceinline__ unsigned xb_xcc_id() { return (unsigned)__builtin_amdgcn_s_getreg((3 << 11) | 20) & 0xFu; }
#define XB_SPIN(cond, bar) do { unsigned _sp = 0; while (cond) { __builtin_amdgcn_s_sleep(1); \
    if ((++_sp & 255u) == 0u) { if (xb_ld(&(bar)[XB_TMO])) break; if (_sp > XB_SPIN_CAP) { atomicAdd(&(bar)[XB_TMO], 1u); break; } } } } while (0)

struct XcdBarrier {
    unsigned* bar; unsigned x;
    volatile LAS unsigned* st;
    int wv;
};

__device__ __forceinline__ XcdBarrier xcd_barrier_post(unsigned* bar, volatile LAS unsigned* st) {
    XcdBarrier b; b.bar = bar; b.x = xb_xcc_id(); b.st = st;
    if (threadIdx.x == 0) (void)xb_add(&bar[XB_XCNT(b.x)], 1u);
    return b;
}
__device__ __forceinline__ void xcd_barrier_complete(unsigned* bar, unsigned x, unsigned& nloc, unsigned& nx) {
    const unsigned G = gridDim.x * gridDim.y * gridDim.z;
    unsigned sum, cnt, mine, sp = 0u;
    for (;;) {
        sum = 0u; cnt = 0u; mine = 0u;
#pragma unroll
        for (unsigned j = 0; j < 16; ++j) { const unsigned c = xb_ld(&bar[XB_XCNT(j)]); sum += c; cnt += (c > 0u) ? 1u : 0u; mine = (j == x) ? c : mine; }
        if (sum == G) break;
        __builtin_amdgcn_s_sleep(1);
        if ((++sp & 255u) == 0u) { if (xb_ld(&bar[XB_TMO])) break; if (sp > XB_SPIN_CAP) { atomicAdd(&bar[XB_TMO], 1u); break; } }
    }
    nloc = mine > 0u ? mine : 1u; nx = cnt > 0u ? cnt : 1u;
}

__device__ __forceinline__ void xcd_barrier(const XcdBarrier& b) {
    asm volatile("s_waitcnt vmcnt(0)" ::: "memory");
    __syncthreads();
    int xb_lane; asm volatile("v_mbcnt_lo_u32_b32 %0, -1, 0\n\tv_mbcnt_hi_u32_b32 %0, -1, %0" : "=v"(xb_lane));
    if (b.wv == 0 && xb_lane == 0) {
        unsigned* bar = b.bar;
        __builtin_amdgcn_s_waitcnt(0);
        unsigned nloc = b.st[0], nx = b.st[1];
        if (nloc == 0u) { xcd_barrier_complete(bar, b.x, nloc, nx); b.st[0] = nloc; b.st[1] = nx; }
        const unsigned old = xb_add(&bar[XB_XSUB(b.x)], 1u);
        const unsigned gen = old / nloc;
        if (old + 1u == (gen + 1u) * nloc) {
            __builtin_amdgcn_fence(__ATOMIC_RELEASE, "agent");
            asm volatile("s_waitcnt vmcnt(0)" ::: "memory");
            const unsigned og = xb_add(&bar[XB_TOP], 1u);
            const unsigned tg = og / nx;
            if (og + 1u == (tg + 1u) * nx) xb_add(&bar[XB_TOPGEN], 1u);
            else XB_SPIN(xb_ld(&bar[XB_TOPGEN]) == tg, bar);
            __builtin_amdgcn_fence(__ATOMIC_ACQUIRE, "agent");
            xb_add(&bar[XB_XGEN(b.x)], 1u);
            asm volatile("s_waitcnt vmcnt(0)" ::: "memory");
        } else {
            XB_SPIN(xb_ld(&bar[XB_XGEN(b.x)]) == gen, bar);
            __builtin_amdgcn_fence(__ATOMIC_ACQUIRE, "agent");
            asm volatile("s_waitcnt vmcnt(0)" ::: "memory");
        }
    }
    __syncthreads();
}


constexpr int LDS_BYTES = 147456;
constexpr int MISC_OFF = 131072 + 320;

struct Args { Ptrs P; unsigned* bar; };
static_assert(sizeof(Ptrs) % 8 == 0, "Ptrs is copied as 64-bit words");

__global__ void __launch_bounds__(512, 2) mega(Args a) {
    extern __shared__ __attribute__((aligned(16))) unsigned char lds[];
    volatile LAS unsigned* MISC = (volatile LAS unsigned*)((LAS unsigned char*)lds + MISC_OFF);
    if (threadIdx.x < 32) MISC[threadIdx.x] = 0u;
    __syncthreads();
    const int wave_s = __builtin_amdgcn_readfirstlane(threadIdx.x >> 6);
    XcdBarrier bar = xcd_barrier_post(a.bar, MISC + 8); bar.wv = wave_s;
    const int bid = blockIdx.x, nblk = gridDim.x;
    float* fl = (float*)lds;
    PG8_LAS unsigned char* glds = (PG8_LAS unsigned char*)lds;
#if defined(__HIP_DEVICE_COMPILE__)
#define PFRESH() const __attribute__((address_space(4))) unsigned long long* kp_ = (const __attribute__((address_space(4))) unsigned long long*)__builtin_amdgcn_kernarg_segment_ptr(); asm volatile("" : "+s"(kp_)); \
                 union { Ptrs P; unsigned long long w[sizeof(Ptrs) / 8]; } pu_; _Pragma("unroll") for (int i_ = 0; i_ < (int)(sizeof(Ptrs) / 8); ++i_) pu_.w[i_] = kp_[i_]; \
                 const Ptrs& P = pu_.P; float* ws = P.ws; (void)ws;
#else
#define PFRESH() const Ptrs& P = a.P; float* ws = P.ws; (void)ws;
#endif
#define FRESH() int lane; asm volatile("v_mbcnt_lo_u32_b32 %0, -1, 0\n\tv_mbcnt_hi_u32_b32 %0, -1, %0" : "=v"(lane)); const int wave = wave_s, tid = wave_s * 64 + lane, gwave = bid * 8 + wave, nwaves = nblk * 8; \
                const size_t gtid = (size_t)bid * 512 + tid, nthr = (size_t)nblk * 512; (void)tid; (void)wave; (void)gwave; (void)nwaves; (void)gtid; (void)nthr; PFRESH();

    const bool defer = (nblk == 256);
#pragma nounroll
    for (int step = 0; step < 3; ++step) {
        const int what = ((bid >> 3) & 1) ? (step == 0 ? 1 : step == 1 ? 0 : 2) : (step == 0 ? 0 : step == 1 ? 2 : 1);
        if (what == 0) { FRESH(); prologue_transposes(P, lds, 0, defer ? TR_P0 : TR_ALL, gwave, nwaves, wave, lane); }
        else if (what == 1) { FRESH(); prologue_wprime(P, fl, bid, nblk, tid); }
        else { FRESH(); prologue_ng(P, gtid, nthr); prologue_cmp(P, gtid, nthr, gwave, nwaves, lane); prologue_state_copies(P, gtid, nthr); rms_stage<0>(P, gwave, nwaves, lane); }
        __syncthreads();
    }
    xcd_barrier(bar);
#pragma nounroll
    for (int step = 0; step < 2; ++step) {
        if (((step ^ (bid >> 3)) & 1) == 0) {
            PFRESH(); pg8::Gemm g{P.ub, P.wt_in, M, NIN, D, D, D}; pg8::StaticOrder S; S.init(M, NIN, nblk, bid); EpiIn E{P.out, ws + W_POOLIN, P.qb, P.kvb, P.gateb};
            pg8::gemm_phase<EpiIn, pg8::StaticOrder, true, true>(glds, g, S, E, wave_s);
        } else {
            { FRESH(); ng_stage(P, bid, nblk, wave, lane); }
            { FRESH(); compress_sample_lds(P, glds, bid, nblk, wave, lane, tid); }
        }
        __syncthreads();
    }
    xcd_barrier(bar);
    if (nblk > 64 && bid >= 32) { FRESH(); pool_stage(P, gtid - (size_t)32 * 512, nthr - (size_t)32 * 512); }
    else if (nblk > 64) { FRESH(); compress_prompt_split(P, glds, bid, wave, lane); }
    else { FRESH(); pool_stage(P, gtid, nthr); compress_mfma<1, true>(P, gwave, nwaves, lane); }
    xcd_barrier(bar);
    if ((bid >> 3) & 1) { { FRESH(); attn_sample_stage(P, glds, bid, nblk, tid); } { FRESH(); attn_prompt_stage(P, glds, bid, nblk, tid); } }
    else { { FRESH(); attn_prompt_stage(P, glds, bid, nblk, tid); } { FRESH(); attn_sample_stage(P, glds, bid, nblk, tid); } }
    xcd_barrier(bar);
    { PFRESH(); pg8::Gemm g{P.xcat, P.wt_pn, MP, D, D, D, D}; pg8::StaticOrder S; S.init(MP, D, nblk, bid); EpiMerge E{P.gateb, P.mergedb};
      pg8::gemm_phase<EpiMerge, pg8::StaticOrder, true, true>(glds, g, S, E, wave_s); }
    { PFRESH(); pg8::Gemm g{P.xcat, P.wt_pn, M, D, 256, D, D}; pg8::SplitOrder S{nblk, bid, 8, 256, MP / 256, D / 256}; pg8::EpiSlab E{(bf16_t*)(ws + W_SLABM), D, 256, MP / 256, (size_t)MS * D};
      pg8::gemm_phase<pg8::EpiSlab, pg8::SplitOrder, true, true>(glds, g, S, E, wave_s); }
    if (defer && bid >= 128) { FRESH(); prologue_transposes(P, lds, TR_P0, TR_SLOTA, (bid - 128) * 8 + wave, 1024, wave, lane); }
    xcd_barrier(bar);
    { FRESH(); merge_sample_stage(P, gtid, nthr); }
    xcd_barrier(bar);
    { PFRESH(); pg8::Gemm g{P.mergedb, P.wt_out, MP, D, D, D, D}; pg8::StaticOrder S; S.init(MP, D, nblk, bid); EpiB16 E{P.tb, D};
      pg8::gemm_phase<EpiB16, pg8::StaticOrder, true, true>(glds, g, S, E, wave_s); }
    { PFRESH(); pg8::Gemm g{P.mergedb, P.wt_out, M, D, 256, D, D}; pg8::SplitOrder S{nblk, bid, 8, 256, MP / 256, D / 256}; pg8::EpiSlab E{(bf16_t*)(ws + W_SLAB), D, 256, MP / 256, (size_t)MS * D};
      pg8::gemm_phase<pg8::EpiSlab, pg8::SplitOrder, true, true>(glds, g, S, E, wave_s); }
    if (defer && bid >= 128) { FRESH(); prologue_transposes(P, lds, TR_SLOTA, TR_UP, (bid - 128) * 8 + wave, 1024, wave, lane); }
    xcd_barrier(bar);
    { FRESH(); rms_stage<1>(P, gwave, nwaves, lane); }
    xcd_barrier(bar);
    { PFRESH(); pg8::Gemm g{P.u2b, P.wt_up, M, 2 * FF, D, D, D}; pg8::StaticOrder S; S.init(M, 2 * FF, nblk, bid); EpiUpAct E{P.actb, P.out, ws, P.conv_w, P.conv_b};
      pg8::gemm_phase<EpiUpAct, pg8::StaticOrder, false, true>(glds, g, S, E, wave_s); }
    if (defer && bid >= 216) { FRESH(); prologue_transposes(P, lds, TR_UP, TR_ALL, (bid - 216) * 8 + wave, 320, wave, lane); }
    xcd_barrier(bar);
    { FRESH(); act_fix_stage(P, gtid, nthr); }
    xcd_barrier(bar);
    { PFRESH(); pg8::Gemm g{P.actb, P.wt_down, MP, D, FF, FF, FF}; pg8::StaticOrder S; S.init(MP, D, nblk, bid); EpiB16 E{P.tb, D};
      pg8::gemm_phase<EpiB16, pg8::StaticOrder, true, true>(glds, g, S, E, wave_s); }
    { PFRESH(); pg8::Gemm g{P.actb, P.wt_down, M, D, 512, FF, FF}; pg8::SplitOrder S{nblk, bid, 11, 512, MP / 256, D / 256}; pg8::EpiSlab E{(bf16_t*)(ws + W_SLAB), D, 512, MP / 256, (size_t)MS * D};
      pg8::gemm_phase<pg8::EpiSlab, pg8::SplitOrder, true, true>(glds, g, S, E, wave_s); }
    xcd_barrier(bar);
    { FRESH(); rms_stage<2>(P, gwave, nwaves, lane); }
#undef FRESH
#undef PFRESH
}
}

extern "C" void kernel_launch(void* const* d_in, const int* in_sizes, int n_in, void* d_out, int out_size, void* d_ws, size_t ws_size, hipStream_t stream) {
    if (n_in != 28 || (size_t)out_size != O_END || ws_size < WS_TOTAL) return;
    static int grid = 0;
    if (grid == 0) {
        int dev = 0, cus = 0, per_cu = 0;
        if (hipGetDevice(&dev) != hipSuccess || hipDeviceGetAttribute(&cus, hipDeviceAttributeMultiprocessorCount, dev) != hipSuccess) { grid = -1; return; }
        if (hipFuncSetAttribute((const void*)mega, hipFuncAttributeMaxDynamicSharedMemorySize, LDS_BYTES) != hipSuccess) { grid = -1; return; }
        if (hipOccupancyMaxActiveBlocksPerMultiprocessor(&per_cu, (const void*)mega, 512, LDS_BYTES) != hipSuccess || per_cu < 1) { (void)hipGetLastError(); per_cu = 1; }
        grid = cus;
    }
    if (grid < 0) return;
    (void)hipMemsetAsync(d_ws, 0, WS_CTL_BYTES, stream);
    Args a{};
    Ptrs& P = a.P;
    P.xp = (const float*)d_in[0]; P.xs = (const float*)d_in[1]; P.cache = (const float*)d_in[2]; P.pt = (const int*)d_in[3]; P.swin = (const float*)d_in[4];
    P.spool = (const float*)d_in[5]; P.sconv = (const float*)d_in[6]; P.g_pre = (const float*)d_in[7]; P.w_in = (const float*)d_in[8];
    P.pe_k = (const float*)d_in[9]; P.w1_k = (const float*)d_in[10]; P.w2_k = (const float*)d_in[11]; P.pe_v = (const float*)d_in[12]; P.w1_v = (const float*)d_in[13]; P.w2_v = (const float*)d_in[14];
    P.rel_bias = (const float*)d_in[15]; P.w_pgrp = (const float*)d_in[16]; P.pool_scale = (const float*)d_in[17]; P.w_pproj = (const float*)d_in[18]; P.w_nproj = (const float*)d_in[19];
    P.w_out = (const float*)d_in[20]; P.g_pmix = (const float*)d_in[21]; P.g_pffn = (const float*)d_in[22]; P.w_up = (const float*)d_in[23]; P.conv_w = (const float*)d_in[24];
    P.conv_b = (const float*)d_in[25]; P.w_down = (const float*)d_in[26]; P.g_postffn = (const float*)d_in[27];
    P.out = (float*)d_out; P.ws = (float*)((char*)d_ws + WS_F32_OFF);
    bf16_t* hb = (bf16_t*)((char*)d_ws + WS_H_OFF);
    P.ub = hb + H_UB; P.xcat = hb + H_XCAT; P.mergedb = hb + H_MERGEDB; P.u2b = hb + H_U2B; P.upb = hb + H_UPB; P.actb = hb + H_ACTB; P.gateb = hb + H_GATEB;
    P.wt_in = hb + H_WTIN; P.wt_ng = hb + H_WTNG; P.wt_pn = hb + H_WTPN; P.wt_out = hb + H_WTOUT; P.wt_up = hb + H_WTUP; P.wt_down = hb + H_WTDOWN;
    P.qb = hb + H_QB; P.kvb = hb + H_KVB; P.kcb = hb + H_KCB; P.vcb = hb + H_VCB; P.w1f = hb + H_W1F; P.w2f = hb + H_W2F; P.tb = hb + H_TB; P.ngs = P.ws + W_NGS; P.c1 = P.ws + W_C1;
    a.bar = (unsigned*)d_ws + 4096;
    hipLaunchKernelGGL(mega, dim3(grid), dim3(512), LDS_BYTES, stream, a);
}
```
